# Optimizing an MI355X kernel written in HIP

```python
import jax, jax.numpy as jnp
from jax import lax
import numpy as np

D_MODEL = 2048
BATCH = 4
SEQ = 4096
DEPTH = 2

HEAD_DIM = 128
EPS = 1e-6
ROPE_THETA = 10000.0
N_EVEN = (DEPTH + 1) // 2
N_ODD = DEPTH // 2

POOL_WINDOWS = (2, 4, 8, 16)
POOL_WIDTH = D_MODEL // 2
POOL_GROUP = POOL_WIDTH // len(POOL_WINDOWS)

DIL_PATTERNS = ((128, 1), (512, 4), (2048, 16))
N_DIL_GROUPS = len(DIL_PATTERNS)
DIL_HEADS = (D_MODEL - POOL_WIDTH) // HEAD_DIM
DIL_QBLOCK = 128
AB_IN = POOL_WIDTH + 3 * N_DIL_GROUPS * DIL_HEADS * HEAD_DIM

SB_HEADS = D_MODEL // HEAD_DIM // 2
SB_QBLOCK = 128
MOBA_HEADS = D_MODEL // HEAD_DIM - SB_HEADS
MOBA_BLOCK = 256
MOBA_TOPK = 3
MOBA_QCHUNK = 16
CD_IN = 3 * (SB_HEADS + MOBA_HEADS) * HEAD_DIM

FFN_HIDDEN = -(-8 * D_MODEL // (3 * 256)) * 256

kernel_name = "hybrid_pool_dilated_stickbreak_moba_block"


def rms_norm(x, g):
    xf = x.astype(jnp.float32)
    y = xf * lax.rsqrt(jnp.mean(xf * xf, axis=-1, keepdims=True) + EPS)
    return (y * g.astype(jnp.float32)).astype(x.dtype)


def rope_tables(seq):
    inv = 1.0 / (ROPE_THETA ** (jnp.arange(0, HEAD_DIM, 2, dtype=jnp.float32) / HEAD_DIM))
    ang = jnp.arange(seq, dtype=jnp.float32)[:, None] * inv[None, :]
    return jnp.cos(ang), jnp.sin(ang)


def apply_rope(x, cos, sin):
    x1, x2 = jnp.split(x.astype(jnp.float32), 2, axis=-1)
    return jnp.concatenate([x1 * cos - x2 * sin, x2 * cos + x1 * sin], axis=-1).astype(x.dtype)


def pool_mixer(u, pool_w, pool_scale):
    Bn, S, _ = u.shape
    uf = u.astype(jnp.float32).reshape(Bn, S, len(POOL_WINDOWS), POOL_GROUP)
    c = jnp.pad(jnp.cumsum(uf, axis=1), ((0, 0), (1, 0), (0, 0), (0, 0)))
    t = jnp.arange(S)
    pooled = []
    for g, w in enumerate(POOL_WINDOWS):
        lo = jnp.maximum(t + 1 - w, 0)
        cg = c[:, :, g]
        cnt = (t + 1 - lo).astype(jnp.float32)[None, :, None]
        pooled.append((cg[:, 1:] - cg[:, lo]) / cnt - uf[:, :, g])
    pooled = jnp.stack(pooled, axis=2)
    y = jnp.einsum('bsgc,gcd->bsgd', pooled.astype(u.dtype), pool_w)
    return y.reshape(Bn, S, POOL_WIDTH) * pool_scale


def dilated_branch(q, k, v, dil, band):
    Bn, H, S, dh = q.shape
    L = S // dil
    nblk = -(-L // DIL_QBLOCK)
    Lp = nblk * DIL_QBLOCK
    QB = DIL_QBLOCK

    def to_blocks(x):
        xs = x.reshape(Bn, H, L, dil, dh).transpose(0, 1, 3, 2, 4)
        xs = jnp.pad(xs, ((0, 0), (0, 0), (0, 0), (0, Lp - L), (0, 0)))
        return xs.reshape(Bn, H, dil, nblk, QB, dh)

    qb, kb, vb = to_blocks(q), to_blocks(k), to_blocks(v)
    prev = lambda x: jnp.pad(x, ((0, 0),) * 3 + ((1, 0), (0, 0), (0, 0)))[:, :, :, :-1]
    kk = jnp.concatenate([prev(kb), kb], axis=4)
    vv = jnp.concatenate([prev(vb), vb], axis=4)
    s = jnp.einsum('bhrnqe,bhrnke->bhrnqk', qb, kk).astype(jnp.float32) * (HEAD_DIM ** -0.5)
    n = jnp.arange(nblk)[:, None, None]
    qg = n * QB + jnp.arange(QB)[None, :, None]
    kg = n * QB + jnp.arange(2 * QB)[None, None, :] - QB
    dist = qg - kg
    mask = (dist >= 0) & (dist <= band) & (kg >= 0)
    s = jnp.where(mask, s, -jnp.inf)
    m = jnp.max(s, axis=-1, keepdims=True)
    p = jnp.exp(s - m)
    den = jnp.sum(p, axis=-1, keepdims=True)
    o = jnp.einsum('bhrnqk,bhrnke->bhrnqe', (p / den).astype(v.dtype), vv)
    lse = (m + jnp.log(den))[..., 0]
    o = o.reshape(Bn, H, dil, Lp, dh)[:, :, :, :L].transpose(0, 1, 3, 2, 4).reshape(Bn, H, S, dh)
    lse = lse.reshape(Bn, H, dil, Lp)[:, :, :, :L].transpose(0, 1, 3, 2).reshape(Bn, H, S)
    return o, lse


def stick_breaking(q, k, v):
    Bn, H, S, dh = q.shape
    nblk = S // SB_QBLOCK
    qb = q.reshape(Bn, H, nblk, SB_QBLOCK, dh).transpose(2, 0, 1, 3, 4)
    kpos = jnp.arange(S)

    def block(args):
        qi, i = args
        z = jnp.einsum('bhqe,bhke->bhqk', qi, k).astype(jnp.float32) * (HEAD_DIM ** -0.5)
        qpos = i * SB_QBLOCK + jnp.arange(SB_QBLOCK)
        mask = kpos[None, :] < qpos[:, None]
        log1m = jnp.where(mask, -jax.nn.softplus(z), 0.0)
        suffix = lax.cumsum(log1m, axis=3, reverse=True) - log1m
        a = jnp.where(mask, jnp.exp(jax.nn.log_sigmoid(z) + suffix), 0.0)
        return jnp.einsum('bhqk,bhke->bhqe', a.astype(v.dtype), v)

    out = lax.map(block, (qb, jnp.arange(nblk)))
    return out.transpose(1, 2, 0, 3, 4).reshape(Bn, H, S, dh)


def moba_attention(q, k, v):
    Bn, H, S, dh = q.shape
    nb = -(-S // MOBA_BLOCK)
    Sp = nb * MOBA_BLOCK
    padk = ((0, 0), (0, 0), (0, Sp - S), (0, 0))
    kblk = jnp.pad(k, padk).reshape(Bn, H, nb, MOBA_BLOCK, dh)
    vblk = jnp.pad(v, padk).reshape(Bn, H, nb, MOBA_BLOCK, dh)
    kmean = jnp.mean(kblk.astype(jnp.float32), axis=3)
    topk = min(MOBA_TOPK, nb)
    nq = S // MOBA_QCHUNK
    qc = q.reshape(Bn, H, nq, MOBA_QCHUNK, dh).transpose(2, 0, 1, 3, 4)
    bi = jnp.arange(Bn)[:, None, None, None]
    hi = jnp.arange(H)[None, :, None, None]
    scale = HEAD_DIM ** -0.5

    def chunk(args):
        qi, c = args
        qpos = c * MOBA_QCHUNK + jnp.arange(MOBA_QCHUNK)
        ob = (c * MOBA_QCHUNK) // MOBA_BLOCK
        gate = jnp.einsum('bhqe,bhne->bhqn', qi.astype(jnp.float32), kmean)
        past = jnp.arange(nb)[None, :] < ob
        gate = jnp.where(past, gate, -jnp.inf)
        gval, gidx = lax.top_k(gate, topk)
        valid = jnp.isfinite(gval)
        ksel = kblk[bi, hi, gidx]
        vsel = vblk[bi, hi, gidx]
        s_sel = jnp.einsum('bhqe,bhqnke->bhqnk', qi, ksel).astype(jnp.float32) * scale
        s_sel = jnp.where(valid[..., None], s_sel, -jnp.inf).reshape(Bn, H, MOBA_QCHUNK, topk * MOBA_BLOCK)
        kown = lax.dynamic_index_in_dim(kblk, ob, axis=2, keepdims=False)
        vown = lax.dynamic_index_in_dim(vblk, ob, axis=2, keepdims=False)
        s_own = jnp.einsum('bhqe,bhke->bhqk', qi, kown).astype(jnp.float32) * scale
        kpos = ob * MOBA_BLOCK + jnp.arange(MOBA_BLOCK)
        s_own = jnp.where(kpos[None, :] <= qpos[:, None], s_own, -jnp.inf)
        p = jax.nn.softmax(jnp.concatenate([s_sel, s_own], axis=-1), axis=-1).astype(v.dtype)
        p_sel = p[..., :topk * MOBA_BLOCK].reshape(Bn, H, MOBA_QCHUNK, topk, MOBA_BLOCK)
        p_own = p[..., topk * MOBA_BLOCK:]
        return (jnp.einsum('bhqnk,bhqnke->bhqe', p_sel, vsel)
                + jnp.einsum('bhqk,bhke->bhqe', p_own, vown))

    out = lax.map(chunk, (qc, jnp.arange(nq)))
    return out.transpose(1, 2, 0, 3, 4).reshape(Bn, H, S, dh)


def mix_ab(h, w_in, pool_w, pool_scale, w_out, cos, sin):
    Bn, S, _ = h.shape
    proj = h @ w_in
    a_out = pool_mixer(proj[..., :POOL_WIDTH], pool_w, pool_scale)
    qkv = proj[..., POOL_WIDTH:].reshape(Bn, S, 3, N_DIL_GROUPS, DIL_HEADS, HEAD_DIM)
    qkv = qkv.transpose(2, 3, 0, 4, 1, 5)
    outs, lses = [], []
    for g, (window, dil) in enumerate(DIL_PATTERNS):
        q = apply_rope(qkv[0, g], cos, sin)
        k = apply_rope(qkv[1, g], cos, sin)
        o, lse = dilated_branch(q, k, qkv[2, g], dil, window // dil)
        outs.append(o)
        lses.append(lse)
    wts = jax.nn.softmax(jnp.stack(lses, axis=0), axis=0)
    o = jnp.sum(wts[..., None] * jnp.stack(outs, axis=0).astype(jnp.float32), axis=0)
    b_out = o.transpose(0, 2, 1, 3).reshape(Bn, S, DIL_HEADS * HEAD_DIM).astype(h.dtype)
    return jnp.concatenate([a_out, b_out], axis=-1) @ w_out


def mix_cd(h, w_in, w_out, cos, sin):
    Bn, S, _ = h.shape
    proj = h @ w_in
    c_w = 3 * SB_HEADS * HEAD_DIM
    sb = proj[..., :c_w].reshape(Bn, S, 3, SB_HEADS, HEAD_DIM).transpose(2, 0, 3, 1, 4)
    mb = proj[..., c_w:].reshape(Bn, S, 3, MOBA_HEADS, HEAD_DIM).transpose(2, 0, 3, 1, 4)
    c_out = stick_breaking(sb[0], sb[1], sb[2])
    d_out = moba_attention(apply_rope(mb[0], cos, sin), apply_rope(mb[1], cos, sin), mb[2])
    cat = jnp.concatenate([c_out, d_out], axis=1)
    return cat.transpose(0, 2, 1, 3).reshape(Bn, S, D_MODEL) @ w_out


def swiglu(h, w_gate, w_up, w_down):
    return (jax.nn.silu(h @ w_gate) * (h @ w_up)) @ w_down


def setup_inputs(seed: int = 0) -> dict:
    key = jax.random.key(seed)
    ks = jax.random.split(key, 12)
    nrm = lambda k, shape, fan: jax.random.normal(k, shape, jnp.float32) * (fan ** -0.5)
    return {
        "x": jax.random.normal(ks[0], (BATCH, SEQ, D_MODEL), jnp.float32),
        "norm_gains": 1.0 + 0.05 * jax.random.normal(ks[1], (DEPTH, 4, D_MODEL), jnp.float32),
        "w_in_ab": nrm(ks[2], (N_EVEN, D_MODEL, AB_IN), D_MODEL),
        "pool_w": nrm(ks[3], (N_EVEN, len(POOL_WINDOWS), POOL_GROUP, POOL_GROUP), POOL_GROUP),
        "pool_scale": 1.0 + 0.1 * jax.random.normal(ks[4], (N_EVEN, POOL_WIDTH), jnp.float32),
        "w_out_ab": nrm(ks[5], (N_EVEN, D_MODEL, D_MODEL), D_MODEL),
        "w_in_cd": nrm(ks[6], (N_ODD, D_MODEL, CD_IN), D_MODEL),
        "w_out_cd": nrm(ks[7], (N_ODD, D_MODEL, D_MODEL), D_MODEL),
        "ffn_gate": nrm(ks[8], (DEPTH, D_MODEL, FFN_HIDDEN), D_MODEL),
        "ffn_up": nrm(ks[9], (DEPTH, D_MODEL, FFN_HIDDEN), D_MODEL),
        "ffn_down": nrm(ks[10], (DEPTH, FFN_HIDDEN, D_MODEL), FFN_HIDDEN),
    }


def reference(x, norm_gains, w_in_ab, pool_w, pool_scale, w_out_ab, w_in_cd, w_out_cd,
              ffn_gate, ffn_up, ffn_down):
    cos, sin = rope_tables(x.shape[1])
    for layer in range(DEPTH):
        g = norm_gains[layer]
        hn = rms_norm(x, g[0])
        i = layer // 2
        if layer % 2 == 0:
            y = mix_ab(hn, w_in_ab[i], pool_w[i], pool_scale[i], w_out_ab[i], cos, sin)
        else:
            y = mix_cd(hn, w_in_cd[i], w_out_cd[i], cos, sin)
        x = x + rms_norm(y, g[1])
        f = swiglu(rms_norm(x, g[2]), ffn_gate[layer], ffn_up[layer], ffn_down[layer])
        x = x + rms_norm(f, g[3])
    return x
```

```cpp
#include <hip/hip_runtime.h>
#include <hip/hip_cooperative_groups.h>
#include <cstdio>
namespace cg = cooperative_groups;

#ifndef MK_ONE_LAUNCH
#define MK_ONE_LAUNCH 1
#endif
#ifndef MK_NPH
#define MK_NPH 16
#endif
#ifndef MK_REP
#define MK_REP 0
#endif

#define LAS __attribute__((address_space(3)))
typedef unsigned short bf16_t;
typedef short bf16x8 __attribute__((ext_vector_type(8)));
typedef short s16x4 __attribute__((ext_vector_type(4)));
typedef float f32x4 __attribute__((ext_vector_type(4)));
typedef unsigned u32x4 __attribute__((ext_vector_type(4)));
typedef unsigned u32x2 __attribute__((ext_vector_type(2)));

constexpr int D_MODEL = 2048, BATCH = 4, SEQ = 4096, MTOK = BATCH * SEQ;
constexpr int AB_IN = 10240, CD_IN = 6144, FFN = 5632;
constexpr float EPS = 1e-6f;
constexpr size_t MiB = 1u << 20;
constexpr size_t WS_COS = 1 * MiB, WS_SIN = 2 * MiB, WS_KMEAN = 3 * MiB, WS_LSE = 4 * MiB;
constexpr int LDH = D_MODEL + 64, LDW = D_MODEL + 64, LDWD = FFN + 64, LDHB = FFN + 64, LDP0 = AB_IN + 64, LDP1 = CD_IN + 64;
constexpr size_t WS_W = 8 * MiB;
constexpr size_t W_IN = 0, W_POOL = (size_t)AB_IN * LDW * 2, W_OUT = W_POOL + 524288, W_GU = W_OUT + (size_t)D_MODEL * LDW * 2, W_DN = W_GU + (size_t)2 * FFN * LDW * 2, W_ENDB = W_DN + (size_t)D_MODEL * LDWD * 2;
static_assert(W_ENDB <= 120 * MiB, "weight region");
constexpr size_t WS_A = 128 * MiB;
constexpr size_t WS_B = 196 * MiB;
constexpr size_t WS_H = 264 * MiB;
constexpr size_t WS_MIX2 = 392 * MiB;
constexpr size_t WS_END = 460 * MiB;
static_assert((size_t)MTOK * LDP0 * 2 <= WS_END - WS_A && (size_t)MTOK * LDH * 2 <= 68 * MiB && WS_B + (size_t)MTOK * LDP1 * 2 <= WS_MIX2 && WS_H + (size_t)MTOK * LDHB * 2 <= WS_END && WS_MIX2 + (size_t)MTOK * LDH * 2 <= WS_END, "d_ws map");
constexpr int LDS_BYTES = 144 * 1024;

__device__ __forceinline__ unsigned f2bf(float f) { unsigned u = __builtin_bit_cast(unsigned, f); return (u + 0x7fffu + ((u >> 16) & 1u)) >> 16; }
__device__ __forceinline__ unsigned pk2(float lo, float hi) { unsigned r; asm("v_cvt_pk_bf16_f32 %0, %1, %2" : "=v"(r) : "v"(lo), "v"(hi)); return r; }
__device__ __forceinline__ float bflo(unsigned w) { return __builtin_bit_cast(float, w << 16); }
__device__ __forceinline__ float bfhi(unsigned w) { return __builtin_bit_cast(float, w & 0xffff0000u); }
__device__ __forceinline__ float wave_sum(float v) {
#pragma unroll
    for (int o = 1; o < 64; o <<= 1) v += __shfl_xor(v, o);
    return v;
}

namespace pg8 {
constexpr int BM = 256, BK = 64, HALF = 128, HTB = HALF * BK * 2, STAGE_BYTES = 8 * HTB, NXCD = 8, WGM = 8;
__host__ __device__ __forceinline__ int lds_byte(int r, int c) { const int st = (r >> 4) * 2 + (c >> 5), rr = r & 15, cc = c & 31, ob = rr * 64 + cc * 2; return st * 1024 + (ob ^ (((ob >> 9) & 1) << 5)); }
__host__ __device__ __forceinline__ void stage_rc(int b, int& R, int& C) { const int st = b / 1024, sb = b % 1024, swz = sb ^ (((sb >> 9) & 1) << 5); R = (st >> 1) * 16 + swz / 64; C = (st & 1) * 32 + (swz % 64) / 2; }
__host__ __device__ __forceinline__ int perm32(int rho) { const int n = rho >> 4, i = rho & 15; return 8 * (i >> 2) + 4 * n + (i & 3); }

struct Unit { int pm, pn; };
struct Gemm { const bf16_t* A; const bf16_t* Bt; int lda, ldb, K, a_koff; };

struct StaticOrder {
    int nM, nN, nwg, G, c;
    __device__ void init(int M, int N, int G_, int c_) { nM = M / BM; nN = N / BM; nwg = nM * nN; G = G_; c = c_; }
    __device__ bool next(int i, Unit& u) const {
        const long L = (long)i * G + c; if (L >= nwg) return false;
        int wgid = (int)L; { const int q = nwg / NXCD, r = nwg % NXCD, xcd = wgid % NXCD, off = wgid / NXCD; wgid = (xcd < r ? xcd * (q + 1) : r * (q + 1) + (xcd - r) * q) + off; }
        const int nig = WGM * nN, gid = wgid / nig, fm = gid * WGM, gsz = (nM - fm) < WGM ? (nM - fm) : WGM;
        u.pm = fm + ((wgid % nig) % gsz); u.pn = (wgid % nig) / gsz; return true;
    }
};

__device__ __forceinline__ unsigned cvt_pk_bf16(float lo, float hi) { unsigned r; asm volatile("v_cvt_pk_bf16_f32 %0, %1, %2" : "=v"(r) : "v"(lo), "v"(hi)); return r; }

template <int MODE> struct Epi {
    bf16_t* O; int ldc;
    const float* colscale;
    const float* cosT; const float* sinT; int rope_lo, rope_hi, km_lo, km_hi; float* kmean;
    __device__ __forceinline__ void operator()(const f32x4 (&acc)[2][2][4][2], const Unit& u, int wr, int wc, int fr, int fq) const {
        const int row0 = u.pm * BM + wr * 64 + fr, colt = u.pn * BM, cin = wc * 32 + 8 * fq;
        if constexpr (MODE == 2) {
            const int col0 = u.pn * 128 + wc * 32 + 8 * fq;
#pragma unroll
            for (int ai = 0; ai < 2; ++ai)
#pragma unroll
                for (int m = 0; m < 4; ++m) { bf16_t* rowp = O + (size_t)(row0 + ai * HALF + m * 16) * ldc + col0; float h[2][4];
#pragma unroll
                    for (int bj = 0; bj < 2; ++bj) { const f32x4 g = acc[ai][bj][m][0], up = acc[ai][bj][m][1];
#pragma unroll
                        for (int j = 0; j < 4; ++j) h[bj][j] = g[j] * __builtin_amdgcn_rcpf(1.0f + __builtin_amdgcn_exp2f(-1.4426950408889634f * g[j])) * up[j]; }
                    u32x4 w; w.x = cvt_pk_bf16(h[0][0], h[0][1]); w.y = cvt_pk_bf16(h[0][2], h[0][3]); w.z = cvt_pk_bf16(h[1][0], h[1][1]); w.w = cvt_pk_bf16(h[1][2], h[1][3]);
                    __builtin_nontemporal_store(w, (u32x4*)rowp); }
            return;
        }
        bool rope = false, km = false;
        if constexpr (MODE == 1) { rope = (colt >= rope_lo && colt < rope_hi); km = (colt >= km_lo && colt < km_hi); }
        if constexpr (MODE == 0) {
            const int colo = colt + 64 * wc + 8 * fq; const bool low = fr < 8;
            f32x4 sc[2][2];
#pragma unroll
            for (int bj = 0; bj < 2; ++bj)
#pragma unroll
                for (int n = 0; n < 2; ++n) sc[bj][n] = colscale ? *(const f32x4*)(colscale + colo + 32 * bj + 4 * n) : (f32x4){1.f, 1.f, 1.f, 1.f};
#pragma unroll
            for (int ai = 0; ai < 2; ++ai)
#pragma unroll
                for (int m = 0; m < 4; ++m) {
                    u32x4 w[2];
#pragma unroll
                    for (int bj = 0; bj < 2; ++bj) { const f32x4 v0 = acc[ai][bj][m][0] * sc[bj][0], v1 = acc[ai][bj][m][1] * sc[bj][1];
                        w[bj].x = cvt_pk_bf16(v0[0], v0[1]); w[bj].y = cvt_pk_bf16(v0[2], v0[3]); w[bj].z = cvt_pk_bf16(v1[0], v1[1]); w[bj].w = cvt_pk_bf16(v1[2], v1[3]); }
                    u32x4 snd, rcv;
                    snd.x = low ? w[1].x : w[0].x; snd.y = low ? w[1].y : w[0].y; snd.z = low ? w[1].z : w[0].z; snd.w = low ? w[1].w : w[0].w;
                    rcv.x = (unsigned)__shfl_xor((int)snd.x, 8); rcv.y = (unsigned)__shfl_xor((int)snd.y, 8); rcv.z = (unsigned)__shfl_xor((int)snd.z, 8); rcv.w = (unsigned)__shfl_xor((int)snd.w, 8);
                    u32x4 dA, dB;
                    dA.x = low ? w[0].x : rcv.x; dA.y = low ? w[0].y : rcv.y; dA.z = low ? w[0].z : rcv.z; dA.w = low ? w[0].w : rcv.w;
                    dB.x = low ? rcv.x : w[1].x; dB.y = low ? rcv.y : w[1].y; dB.z = low ? rcv.z : w[1].z; dB.w = low ? rcv.w : w[1].w;
                    bf16_t* pA = O + (size_t)(u.pm * BM + wr * 64 + ai * HALF + m * 16 + (fr & 7)) * ldc + colo + (low ? 0 : 32);
                    __builtin_nontemporal_store(dA, (u32x4*)pA); __builtin_nontemporal_store(dB, (u32x4*)(pA + (size_t)8 * ldc)); }
            return;
        }
        if (!rope) {
#pragma unroll
            for (int ai = 0; ai < 2; ++ai)
#pragma unroll
                for (int m = 0; m < 4; ++m) { bf16_t* rowp = O + (size_t)(row0 + ai * HALF + m * 16) * ldc + colt + cin;
#pragma unroll
                    for (int bj = 0; bj < 2; ++bj) { const f32x4 v0 = acc[ai][bj][m][0], v1 = acc[ai][bj][m][1];
                        u32x4 w; w.x = cvt_pk_bf16(v0[0], v0[1]); w.y = cvt_pk_bf16(v0[2], v0[3]); w.z = cvt_pk_bf16(v1[0], v1[1]); w.w = cvt_pk_bf16(v1[2], v1[3]);
                        *(u32x4*)(rowp + bj * HALF) = w; } }
            return;
        }
        if constexpr (MODE == 1) {
            const int e0 = 16 * wc + 4 * fq;
            f32x4 ks[2][2];
#pragma unroll
            for (int bj = 0; bj < 2; ++bj) { ks[bj][0] = (f32x4){0.f, 0.f, 0.f, 0.f}; ks[bj][1] = (f32x4){0.f, 0.f, 0.f, 0.f}; }
#pragma unroll
            for (int ai = 0; ai < 2; ++ai)
#pragma unroll
                for (int m = 0; m < 4; ++m) { const int row = row0 + ai * HALF + m * 16, t = row & (SEQ - 1);
                    const f32x4 c4 = *(const f32x4*)(cosT + t * 64 + e0), s4 = *(const f32x4*)(sinT + t * 64 + e0);
                    bf16_t* rowp = O + (size_t)row * ldc + colt + cin;
#pragma unroll
                    for (int bj = 0; bj < 2; ++bj) { const f32x4 x1 = acc[ai][bj][m][0], x2 = acc[ai][bj][m][1];
                        const f32x4 o1 = x1 * c4 - x2 * s4, o2 = x2 * c4 + x1 * s4;
                        ks[bj][0] += o1; ks[bj][1] += o2;
                        u32x4 w; w.x = cvt_pk_bf16(o1[0], o1[1]); w.y = cvt_pk_bf16(o1[2], o1[3]); w.z = cvt_pk_bf16(o2[0], o2[1]); w.w = cvt_pk_bf16(o2[2], o2[3]);
                        *(u32x4*)(rowp + bj * HALF) = w; } }
            if (km) {
                const int b = u.pm >> 4, blk = u.pm & 15;
#pragma unroll
                for (int bj = 0; bj < 2; ++bj) { const int h = (colt + bj * HALF - km_lo) >> 7;
#pragma unroll
                    for (int n = 0; n < 2; ++n)
#pragma unroll
                        for (int j = 0; j < 4; ++j) { float v = ks[bj][n][j];
                            v += __shfl_xor(v, 1); v += __shfl_xor(v, 2); v += __shfl_xor(v, 4); v += __shfl_xor(v, 8);
                            if (fr == 0) atomicAdd(kmean + ((size_t)((b * 8 + h) * 16 + blk)) * 128 + cin + 4 * n + j, v * (1.0f / 256.0f)); } }
            }
        }
    }
};

template <class EpiT>
__device__ __forceinline__ void gemm_phase(LAS unsigned char* lds, const Gemm g, const StaticOrder& S, const EpiT& E) {
    const int tid = threadIdx.x, wid = __builtin_amdgcn_readfirstlane(tid >> 6), lane = tid & 63, wr = wid >> 2, wc = wid & 3, fr = lane & 15, fq = lane >> 4;
    const int K = g.K, nt = K / BK;
    unsigned voffA[2], voffB[2];
#pragma unroll
    for (int i = 0; i < 2; ++i) { int R, C; stage_rc(tid * 16 + i * 8192, R, C); const int Rb = (R & ~31) + perm32(R & 31);
        voffA[i] = (unsigned)(R * g.lda + C) * 2u; voffB[i] = (unsigned)(Rb * g.ldb + C) * 2u; }
    const size_t kstep = (size_t)(BK * 2);
    const size_t hstepA = (size_t)HALF * g.lda * 2, hstepB = (size_t)HALF * g.ldb * 2;
    const size_t tstepA = 2 * hstepA, tstepB = 2 * hstepB;
    const unsigned ldsw = (unsigned)wid * 1024u;
    const int aoff = lds_byte(wr * 64 + fr, fq * 8), boff = lds_byte(wc * 32 + fr, fq * 8);
#define PG8_SA(b, h) (((b) * 2 + (h)) * HTB)
#define PG8_SB(b, h) ((4 + (b) * 2 + (h)) * HTB)
#define PG8_STAGE(bufoff, gbase, voff) do { _Pragma("unroll") for (int _i = 0; _i < 2; ++_i) \
        __builtin_amdgcn_global_load_lds((const unsigned*)((const char*)(gbase) + (voff)[_i]), (LAS unsigned*)(lds + (bufoff) + ldsw + _i * 8192), 16, 0, 0); } while (0)
#define PG8_LDA(dst, b, h) do { _Pragma("unroll") for (int m = 0; m < 4; ++m) _Pragma("unroll") for (int k = 0; k < 2; ++k) dst[m][k] = *(const LAS bf16x8*)(lds + PG8_SA(b, h) + aoff + m * 2048 + k * 1024); } while (0)
#define PG8_LDB(dst, b, h) do { _Pragma("unroll") for (int n = 0; n < 2; ++n) _Pragma("unroll") for (int k = 0; k < 2; ++k) dst[n][k] = *(const LAS bf16x8*)(lds + PG8_SB(b, h) + boff + n * 2048 + k * 1024); } while (0)
#define PG8_MMA(ai, bj, At, Bt) do { __builtin_amdgcn_s_setprio(1); _Pragma("unroll") for (int m = 0; m < 4; ++m) _Pragma("unroll") for (int n = 0; n < 2; ++n) _Pragma("unroll") for (int k = 0; k < 2; ++k) \
        acc[ai][bj][m][n] = __builtin_amdgcn_mfma_f32_16x16x32_bf16(Bt[n][k], At[m][k], acc[ai][bj][m][n], 0, 0, 0); __builtin_amdgcn_s_setprio(0); } while (0)
#define PG8_WAIT_V(n) asm volatile("s_waitcnt vmcnt(" #n ")" ::: "memory")
#define PG8_WAIT_L(n) asm volatile("s_waitcnt lgkmcnt(" #n ")" ::: "memory")
#define PG8_BAR __builtin_amdgcn_s_barrier()
#define PG8_SCHED __builtin_amdgcn_sched_barrier(0)
    Unit cur, nxt; int ui = 0;
    if (!S.next(0, cur)) return;
    f32x4 acc[2][2][4][2];
#pragma unroll
    for (int a = 0; a < 2; ++a)
#pragma unroll
        for (int b = 0; b < 2; ++b)
#pragma unroll
            for (int m = 0; m < 4; ++m)
#pragma unroll
                for (int n = 0; n < 2; ++n) acc[a][b][m][n] = (f32x4){0.f, 0.f, 0.f, 0.f};
    bf16x8 At[4][2], B0[2][2], B1[2][2];
    const char* cA = (const char*)g.A + (size_t)cur.pm * tstepA + (size_t)cur.pn * g.a_koff * 2; const char* cB = (const char*)g.Bt + (size_t)cur.pn * tstepB;
    PG8_STAGE(PG8_SB(0, 0), cB, voffB); PG8_STAGE(PG8_SB(0, 1), cB + hstepB, voffB); PG8_STAGE(PG8_SA(0, 0), cA, voffA); PG8_STAGE(PG8_SA(0, 1), cA + hstepA, voffA);
    if (wr == 1) PG8_BAR;
    PG8_WAIT_V(2); PG8_BAR;
    PG8_STAGE(PG8_SB(1, 0), cB + kstep, voffB); PG8_STAGE(PG8_SA(1, 0), cA + kstep, voffA); PG8_STAGE(PG8_SB(1, 1), cB + hstepB + kstep, voffB);
    PG8_WAIT_V(6); PG8_BAR;
    for (;;) {
        const bool has_next = S.next(ui + 1, nxt);
        const char* nA = has_next ? (const char*)g.A + (size_t)nxt.pm * tstepA + (size_t)nxt.pn * g.a_koff * 2 : cA; const char* nB = has_next ? (const char*)g.Bt + (size_t)nxt.pn * tstepB : cB;
        for (int t = 0; t < nt; t += 2) {
            const bool last = (t == nt - 2);
            const char* a1 = cA + (size_t)(t + 1) * kstep;
            const char* a2 = last ? nA : cA + (size_t)(t + 2) * kstep; const char* b2 = last ? nB : cB + (size_t)(t + 2) * kstep;
            const char* a3 = a2 + kstep; const char* b3 = b2 + kstep;
            PG8_LDB(B0, 0, 0); PG8_LDB(B1, 0, 1); PG8_SCHED; PG8_LDA(At, 0, 0); PG8_STAGE(PG8_SA(1, 1), a1 + hstepA, voffA);
            PG8_WAIT_V(8); PG8_WAIT_L(0); PG8_BAR; PG8_MMA(0, 0, At, B0); PG8_MMA(0, 1, At, B1); PG8_BAR; PG8_SCHED;
            PG8_LDA(At, 0, 1); PG8_STAGE(PG8_SB(0, 0), b2, voffB); PG8_STAGE(PG8_SB(0, 1), b2 + hstepB, voffB); PG8_STAGE(PG8_SA(0, 0), a2, voffA);
            PG8_WAIT_V(8); PG8_WAIT_L(0); PG8_BAR; PG8_MMA(1, 0, At, B0); PG8_MMA(1, 1, At, B1); PG8_BAR; PG8_SCHED;
            PG8_LDB(B0, 1, 0); PG8_LDB(B1, 1, 1); PG8_SCHED; PG8_LDA(At, 1, 0); PG8_STAGE(PG8_SA(0, 1), a2 + hstepA, voffA);
            PG8_WAIT_V(8); PG8_WAIT_L(0); PG8_BAR; PG8_MMA(0, 0, At, B0); PG8_MMA(0, 1, At, B1); PG8_BAR; PG8_SCHED;
            PG8_LDA(At, 1, 1); PG8_STAGE(PG8_SB(1, 0), b3, voffB); PG8_STAGE(PG8_SB(1, 1), b3 + hstepB, voffB); PG8_STAGE(PG8_SA(1, 0), a3, voffA);
            PG8_WAIT_V(8); PG8_WAIT_L(0); PG8_BAR; PG8_MMA(1, 0, At, B0); PG8_MMA(1, 1, At, B1); PG8_BAR; PG8_SCHED;
        }
        if (wr == 0) PG8_BAR;
        E(acc, cur, wr, wc, fr, fq);
        if (!has_next) break;
#pragma unroll
        for (int a = 0; a < 2; ++a)
#pragma unroll
            for (int b = 0; b < 2; ++b)
#pragma unroll
                for (int m = 0; m < 4; ++m)
#pragma unroll
                    for (int n = 0; n < 2; ++n) acc[a][b][m][n] = (f32x4){0.f, 0.f, 0.f, 0.f};
        cur = nxt; cA = nA; cB = nB; ++ui;
        if (wr == 1) PG8_BAR;
    }
    PG8_WAIT_V(0);
    PG8_BAR;
#undef PG8_SA
#undef PG8_SB
#undef PG8_STAGE
#undef PG8_LDA
#undef PG8_LDB
#undef PG8_MMA
#undef PG8_WAIT_V
#undef PG8_WAIT_L
#undef PG8_BAR
#undef PG8_SCHED
}
}

namespace att {
constexpr int ROWB = 288, KOFF = 0, VOFF = 64 * ROWB, BUFB = 2 * 64 * ROWB, KM_OFF = 3 * BUFB, GATE_OFF = KM_OFF + 8192, SEL_OFF = GATE_OFF + 16384, DONE_OFF = SEL_OFF + 1024;
enum { DIL = 0, SB = 1, MOBA = 2 };
constexpr float SCALE = 0.08838834764831845f, LOG2E = 1.4426950408889634f, SCL2 = SCALE * LOG2E;
#define MFMA16(a, b, c) __builtin_amdgcn_mfma_f32_16x16x32_bf16((a), (b), (c), 0, 0, 0)

template <int MODE>
__device__ __forceinline__ void unit(LAS unsigned char* lds, const bf16_t* Qp, const bf16_t* Kp, const bf16_t* Vp, bf16_t* Op, int ld, int ldo, int rowbase, int rowstride,
                                     int q0, int kstart, int ntiles, float* lse_out, int ob) {
    int tid_ = threadIdx.x; asm volatile("" : "+v"(tid_));
    const int tid = tid_, lane = tid & 63, wid = __builtin_amdgcn_readfirstlane(tid >> 6), c15 = lane & 15, g = lane >> 4;
    const int qw0 = q0 + 32 * wid;
    const bool hiw = wid >= 4;
    bf16x8 qf[2][4];
#pragma unroll
    for (int qt = 0; qt < 2; ++qt) { const int qrow = rowbase + (qw0 + 16 * qt + c15) * rowstride;
#pragma unroll
        for (int ks = 0; ks < 4; ++ks) qf[qt][ks] = *(const bf16x8*)(Qp + (size_t)qrow * ld + 32 * ks + 8 * g); }
    f32x4 o[2][8];
#pragma unroll
    for (int qt = 0; qt < 2; ++qt)
#pragma unroll
        for (int dt = 0; dt < 8; ++dt) o[qt][dt] = (f32x4){0.f, 0.f, 0.f, 0.f};
    float mrun[2] = {-1e30f, -1e30f}, lrun[2] = {0.f, 0.f}, Rrun[2] = {1.f, 1.f};
    const int srow = tid >> 4, sch = tid & 15;
    u32x4 kr[2], vr[2];
#define ATT_LOAD(kp0_) do { _Pragma("unroll") for (int _i = 0; _i < 2; ++_i) { const int _grow = rowbase + ((kp0_) + srow + 32 * _i) * rowstride; \
        kr[_i] = *(const u32x4*)(Kp + (size_t)_grow * ld + sch * 8); vr[_i] = *(const u32x4*)(Vp + (size_t)_grow * ld + sch * 8); } } while (0)
#define ATT_KP0(i_) ((MODE == SB) ? (kstart + 64 * (ntiles - 1 - (i_))) : (kstart + 64 * (i_)))
#define ATT_PV(tb_) do { _Pragma("unroll") for (int st = 0; st < 2; ++st) { __builtin_amdgcn_sched_barrier(0); \
        const LAS unsigned char* vb = (tb_) + VOFF + (32 * st + 4 * g + (c15 >> 2)) * ROWB + (c15 & 3) * 8; \
        _Pragma("unroll") for (int dt = 0; dt < 8; ++dt) { \
            const s16x4 a0 = __builtin_amdgcn_ds_read_tr16_b64_v4i16((LAS s16x4*)(vb + dt * 32)); \
            const s16x4 a1 = __builtin_amdgcn_ds_read_tr16_b64_v4i16((LAS s16x4*)(vb + 16 * ROWB + dt * 32)); \
            const bf16x8 vf = __builtin_shufflevector(a0, a1, 0, 1, 2, 3, 4, 5, 6, 7); \
            _Pragma("unroll") for (int qt = 0; qt < 2; ++qt) o[qt][dt] = MFMA16(vf, pf[qt][st], o[qt][dt]); } } } while (0)
    bf16x8 pf[2][2]; bool pend = false; int bcur = 0, bprev = 0;
    ATT_LOAD(ATT_KP0(0));
#pragma unroll
    for (int i = 0; i < 2; ++i) { *(LAS u32x4*)(lds + KOFF + (srow + 32 * i) * ROWB + sch * 16) = kr[i]; *(LAS u32x4*)(lds + VOFF + (srow + 32 * i) * ROWB + sch * 16) = vr[i]; }
    __syncthreads();
    for (int it = 0; it < ntiles; ++it) {
        if constexpr (MODE == SB) { if (it > 0) {
            const u32x4 d0 = *(const LAS u32x4*)(lds + DONE_OFF + ((it - 1) & 1) * 32), d1 = *(const LAS u32x4*)(lds + DONE_OFF + ((it - 1) & 1) * 32 + 16);
            if ((d0.x & d0.y & d0.z & d0.w & d1.x & d1.y & d1.z & d1.w) != 0u) break; } }
        if (it + 1 < ntiles) ATT_LOAD(ATT_KP0(it + 1));
        LAS unsigned char* const tb = lds + bcur * BUFB;
        if (hiw && pend) { ATT_PV(lds + bprev * BUFB); pend = false; }
        const int kp0 = ATT_KP0(it);
        bool active; bool own = false; int bjk = 0;
        unsigned selq[2] = {0u, 0u};
        if constexpr (MODE == MOBA) { selq[0] = ((const LAS unsigned*)(lds + SEL_OFF))[32 * wid + c15]; selq[1] = ((const LAS unsigned*)(lds + SEL_OFF))[32 * wid + 16 + c15]; }
        if constexpr (MODE == DIL) active = !((kp0 > qw0 + 31) || (kp0 + 63 < qw0 - 128));
        else if constexpr (MODE == SB) active = (kp0 < qw0 + 31) && __any((Rrun[0] != 0.f) || (Rrun[1] != 0.f));
        else { own = (kp0 >= q0); bjk = kp0 >> 8; active = own ? (kp0 <= qw0 + 31) : (__any((int)(((selq[0] | selq[1]) >> bjk) & 1u)) != 0); }
        if (active) {
            f32x4 s[2][4];
#pragma unroll
            for (int qt = 0; qt < 2; ++qt)
#pragma unroll
                for (int kt = 0; kt < 4; ++kt) s[qt][kt] = (f32x4){0.f, 0.f, 0.f, 0.f};
            const LAS unsigned char* kb = tb + KOFF + c15 * ROWB + g * 16;
#pragma unroll
            for (int ks = 0; ks < 4; ++ks) {
#pragma unroll
                for (int kt = 0; kt < 4; ++kt) { const bf16x8 kf = *(const LAS bf16x8*)(kb + kt * 16 * ROWB + ks * 64);
#pragma unroll
                    for (int qt = 0; qt < 2; ++qt) s[qt][kt] = MFMA16(kf, qf[qt][ks], s[qt][kt]); }
            }
#pragma unroll
            for (int qt = 0; qt < 2; ++qt) {
                const int qp = qw0 + 16 * qt + c15;
                float p[4][4];
                if constexpr (MODE == SB) {
                    float bp[4][4], E[4], tot[4];
#pragma unroll
                    for (int kt = 0; kt < 4; ++kt) { float r[4], beta[4];
#pragma unroll
                        for (int j = 0; j < 4; ++j) { const int kp = kp0 + 16 * kt + 4 * g + j;
                            float z = s[qt][kt][j] * SCALE; z = fminf(fmaxf(z, -80.f), 80.f);
                            const float en = __builtin_amdgcn_exp2f(-LOG2E * z); const float b = __builtin_amdgcn_rcpf(1.0f + en); const float rr = en * b;
                            const bool valid = kp < qp; beta[j] = valid ? b : 0.f; r[j] = valid ? rr : 1.f; }
                        const float P1 = r[3] * r[2], P0 = P1 * r[1];
                        bp[kt][3] = beta[3]; bp[kt][2] = beta[2] * r[3]; bp[kt][1] = beta[1] * P1; bp[kt][0] = beta[0] * P0;
                        const float T = P0 * r[0];
                        const float Tx = __shfl_xor(T, 16), pair = T * Tx, U = __shfl_xor(pair, 32);
                        E[kt] = (g == 0) ? Tx * U : (g == 1) ? U : (g == 2) ? Tx : 1.0f; tot[kt] = pair * U; }
                    float R = Rrun[qt];
#pragma unroll
                    for (int kk = 0; kk < 4; ++kk) { const int kt = 3 - kk; const float base = E[kt] * R;
#pragma unroll
                        for (int j = 0; j < 4; ++j) p[kt][j] = bp[kt][j] * base;
                        R *= tot[kt]; }
                    Rrun[qt] = R;
                } else {
                    bool umask, lv = true;
                    if constexpr (MODE == DIL) umask = (kp0 >= qw0 - 97) && (kp0 + 63 <= qw0);
                    else { umask = own ? (kp0 + 63 <= qw0) : true; lv = own ? true : (((selq[qt] >> bjk) & 1u) != 0u); }
                    float mx, alpha, mnew, rs = 0.f;
                    if (umask) {
                        float mxr = s[qt][0][0];
#pragma unroll
                        for (int kt = 0; kt < 4; ++kt)
#pragma unroll
                            for (int j = 0; j < 4; ++j) mxr = fmaxf(mxr, s[qt][kt][j]);
                        mx = lv ? mxr * SCL2 : -1e30f;
                        mx = fmaxf(mx, __shfl_xor(mx, 16)); mx = fmaxf(mx, __shfl_xor(mx, 32));
                        mnew = fmaxf(mrun[qt], mx); alpha = __builtin_amdgcn_exp2f(mrun[qt] - mnew); mrun[qt] = mnew;
                        const float cc = lv ? -mnew : -3e30f;
#pragma unroll
                        for (int kt = 0; kt < 4; ++kt)
#pragma unroll
                            for (int j = 0; j < 4; ++j) { p[kt][j] = __builtin_amdgcn_exp2f(__builtin_fmaf(s[qt][kt][j], SCL2, cc)); rs += p[kt][j]; }
                    } else {
                        mx = -1e30f;
#pragma unroll
                        for (int kt = 0; kt < 4; ++kt)
#pragma unroll
                            for (int j = 0; j < 4; ++j) { const int kp = kp0 + 16 * kt + 4 * g + j; bool valid;
                                if constexpr (MODE == DIL) valid = (kp <= qp) && (qp - kp <= 128);
                                else valid = own ? (kp <= qp) : (((selq[qt] >> bjk) & 1u) != 0u);
                                p[kt][j] = valid ? s[qt][kt][j] * SCL2 : -1e30f; mx = fmaxf(mx, p[kt][j]); }
                        mx = fmaxf(mx, __shfl_xor(mx, 16)); mx = fmaxf(mx, __shfl_xor(mx, 32));
                        mnew = fmaxf(mrun[qt], mx); alpha = __builtin_amdgcn_exp2f(mrun[qt] - mnew); mrun[qt] = mnew;
#pragma unroll
                        for (int kt = 0; kt < 4; ++kt)
#pragma unroll
                            for (int j = 0; j < 4; ++j) { p[kt][j] = __builtin_amdgcn_exp2f(p[kt][j] - mnew); rs += p[kt][j]; }
                    }
                    rs += __shfl_xor(rs, 16); rs += __shfl_xor(rs, 32);
                    lrun[qt] = lrun[qt] * alpha + rs;
                    if (__any(alpha != 1.0f)) {
#pragma unroll
                        for (int dt = 0; dt < 8; ++dt) o[qt][dt] *= alpha; }
                }
#pragma unroll
                for (int st = 0; st < 2; ++st) { u32x4 w; w.x = pk2(p[2 * st][0], p[2 * st][1]); w.y = pk2(p[2 * st][2], p[2 * st][3]); w.z = pk2(p[2 * st + 1][0], p[2 * st + 1][1]); w.w = pk2(p[2 * st + 1][2], p[2 * st + 1][3]);
                    pf[qt][st] = __builtin_bit_cast(bf16x8, w); }
            }
            if (hiw) pend = true; else ATT_PV(tb);
        }
        if (it + 1 < ntiles) {
            LAS unsigned char* const nb = lds + (bcur == 2 ? 0 : bcur + 1) * BUFB;
#pragma unroll
            for (int i = 0; i < 2; ++i) { *(LAS u32x4*)(nb + KOFF + (srow + 32 * i) * ROWB + sch * 16) = kr[i]; *(LAS u32x4*)(nb + VOFF + (srow + 32 * i) * ROWB + sch * 16) = vr[i]; }
        }
        if constexpr (MODE == SB) { if (lane == 0) ((LAS unsigned*)(lds + DONE_OFF + (it & 1) * 32))[wid] = __any((Rrun[0] != 0.f) || (Rrun[1] != 0.f)) ? 0u : 1u; }
        __syncthreads();
        bprev = bcur; bcur = bcur == 2 ? 0 : bcur + 1;
    }
    if (hiw && pend) ATT_PV(lds + bprev * BUFB);
    __syncthreads();
#undef ATT_PV
#undef ATT_LOAD
#undef ATT_KP0
#pragma unroll
    for (int qt = 0; qt < 2; ++qt) {
        const int orow = rowbase + (qw0 + 16 * qt + c15) * rowstride;
        const float inv = (MODE == SB) ? 1.0f : 1.0f / lrun[qt];
#pragma unroll
        for (int dt = 0; dt < 8; ++dt) { const f32x4 v = o[qt][dt] * inv; u32x2 w; w.x = pk2(v[0], v[1]); w.y = pk2(v[2], v[3]);
            *(u32x2*)(Op + (size_t)orow * ldo + 16 * dt + 4 * g) = w; }
        if constexpr (MODE == DIL) { if (g == 0) lse_out[(size_t)orow * 8] = (mrun[qt] + __builtin_amdgcn_logf(lrun[qt])) * 0.6931471805599453f; }
    }
}

__device__ __forceinline__ void moba_select(LAS unsigned char* lds, const bf16_t* Qp, int ld, int rowbase, int ob, const float* kmean_bh) {
    const int tid = threadIdx.x;
    LAS float* km_s = (LAS float*)(lds + KM_OFF); LAS float* gate_s = (LAS float*)(lds + GATE_OFF); LAS unsigned* sel_s = (LAS unsigned*)(lds + SEL_OFF);
    __syncthreads();
    ((LAS f32x4*)km_s)[tid] = ((const f32x4*)kmean_bh)[tid];
    __syncthreads();
    { const int q = tid >> 1, par = tid & 1; const bf16_t* qrow = Qp + (size_t)(rowbase + ob * 256 + q) * ld;
      float acc[8];
#pragma unroll
      for (int jj = 0; jj < 8; ++jj) acc[jj] = 0.f;
      for (int c = 0; c < 16; ++c) {
          const u32x4 qv = *(const u32x4*)(qrow + c * 8);
          float qfv[8]; qfv[0] = bflo(qv.x); qfv[1] = bfhi(qv.x); qfv[2] = bflo(qv.y); qfv[3] = bfhi(qv.y); qfv[4] = bflo(qv.z); qfv[5] = bfhi(qv.z); qfv[6] = bflo(qv.w); qfv[7] = bfhi(qv.w);
#pragma unroll
          for (int jj = 0; jj < 8; ++jj) { const int j = 2 * jj + par;
              if (j < ob) { const LAS float* km = km_s + j * 128 + c * 8; const f32x4 ka = *(const LAS f32x4*)km, kb = *(const LAS f32x4*)(km + 4);
                  acc[jj] += qfv[0] * ka[0] + qfv[1] * ka[1] + qfv[2] * ka[2] + qfv[3] * ka[3] + qfv[4] * kb[0] + qfv[5] * kb[1] + qfv[6] * kb[2] + qfv[7] * kb[3]; } }
      }
#pragma unroll
      for (int jj = 0; jj < 8; ++jj) gate_s[q * 16 + 2 * jj + par] = acc[jj]; }
    __syncthreads();
    if (tid < 256) {
        float gq[16];
#pragma unroll
        for (int j4 = 0; j4 < 4; ++j4) { const f32x4 v = *(const LAS f32x4*)(gate_s + tid * 16 + 4 * j4); gq[4 * j4] = v[0]; gq[4 * j4 + 1] = v[1]; gq[4 * j4 + 2] = v[2]; gq[4 * j4 + 3] = v[3]; }
        unsigned sel = 0u;
#pragma unroll
        for (int pick = 0; pick < 3; ++pick) { float best = -3.0e38f; int bi = -1;
#pragma unroll
            for (int j = 0; j < 16; ++j) { const bool ok = (j < ob) && (((sel >> j) & 1u) == 0u) && (gq[j] > best); best = ok ? gq[j] : best; bi = ok ? j : bi; }
            if (bi >= 0) sel |= 1u << bi; }
        sel_s[tid] = sel;
    }
    __syncthreads();
}
}

__device__ __forceinline__ int il128(int e) { return 8 * ((e & 63) >> 2) + 4 * (e >> 6) + (e & 3); }
__device__ __forceinline__ void tr_item(const float* W, int K, int N, bf16_t* WT, int ldt, LAS float* scr, int item, int lane, int mapmode, int p0, int p1) {
    const int nblk = N / 32, kb = item / nblk, nb = item % nblk, k0 = 64 * kb, n0 = 32 * nb;
#pragma unroll 8
    for (int i = 0; i < 32; ++i) { const int kk = 2 * i + (lane >> 5); scr[kk * 33 + (lane & 31)] = W[(size_t)(k0 + kk) * N + n0 + (lane & 31)]; }
    asm volatile("s_waitcnt lgkmcnt(0)" ::: "memory");
    const int c = lane & 7;
#pragma unroll
    for (int j = 0; j < 4; ++j) { const int n = (lane >> 3) + 8 * j; const LAS float* s = scr + (8 * c) * 33 + n;
        u32x4 o; o.x = pk2(s[0 * 33], s[1 * 33]); o.y = pk2(s[2 * 33], s[3 * 33]); o.z = pk2(s[4 * 33], s[5 * 33]); o.w = pk2(s[6 * 33], s[7 * 33]);
        const int ns = n0 + n; int dst;
        if (mapmode == 0) dst = p0 + (ns & ~255) + 128 * ((ns >> 5) & 1) + 32 * ((ns >> 6) & 3) + (ns & 31);
        else if (mapmode == 1) dst = (ns >= p0 && ns < p1) ? ((ns & ~127) + il128(ns & 127)) : ns;
        else dst = 256 * (ns >> 7) + 128 * ((ns >> 2) & 1) + 32 * ((ns >> 5) & 3) + 8 * ((ns >> 3) & 3) + 4 * p0 + (ns & 3);
        *(u32x4*)(WT + (size_t)dst * ldt + k0 + 8 * c) = o; }
    asm volatile("s_waitcnt lgkmcnt(0)" ::: "memory");
}

struct Args { const float* x; const float* gains; const float* w_in_ab; const float* pool_w; const float* pool_scale; const float* w_out_ab; const float* w_in_cd; const float* w_out_cd;
              const float* ffn_gate; const float* ffn_up; const float* ffn_down; float* out; unsigned char* ws; int ph_lo, ph_hi; };

__device__ __forceinline__ void convert_weights(const Args& a, int layer, LAS unsigned char* lds, int gw, int NGW, int wid, int lane) {
    LAS float* scr = (LAS float*)(lds + wid * 16384);
    bf16_t* wb = (bf16_t*)(a.ws + WS_W);
    bf16_t* w_in = wb + W_IN / 2; bf16_t* w_pool = wb + W_POOL / 2; bf16_t* w_out = wb + W_OUT / 2; bf16_t* w_gu = wb + W_GU / 2; bf16_t* w_dn = wb + W_DN / 2;
    const int NIN = layer == 0 ? AB_IN : CD_IN;
    const int I_IN = 32 * (NIN / 32), I_POOL = layer == 0 ? 4 * 4 * 8 : 0, I_OUT = 32 * 64, I_G = 32 * (FFN / 32), I_D = (FFN / 64) * 64;
    const int NIT = I_IN + I_POOL + I_OUT + 2 * I_G + I_D;
    const float* Win = layer == 0 ? a.w_in_ab : a.w_in_cd; const float* Wout = layer == 0 ? a.w_out_ab : a.w_out_cd;
    const int rlo = layer == 0 ? 1024 : 3072, rhi = layer == 0 ? 7168 : 5120;
    const float* Wg = a.ffn_gate + (size_t)layer * D_MODEL * FFN; const float* Wu = a.ffn_up + (size_t)layer * D_MODEL * FFN; const float* Wd = a.ffn_down + (size_t)layer * D_MODEL * FFN;
    for (int it = gw; it < NIT; it += NGW) {
        int r = it;
        if (r < I_IN) { tr_item(Win, D_MODEL, NIN, w_in, LDW, scr, r, lane, 1, rlo, rhi); continue; } r -= I_IN;
        if (r < I_POOL) { const int gi = r >> 5; tr_item(a.pool_w + gi * 65536, 256, 256, w_pool, 256, scr, r & 31, lane, 0, gi * 256, 0); continue; } r -= I_POOL;
        if (r < I_OUT) { tr_item(Wout, D_MODEL, D_MODEL, w_out, LDW, scr, r, lane, 0, 0, 0); continue; } r -= I_OUT;
        if (r < I_G) { tr_item(Wg, D_MODEL, FFN, w_gu, LDW, scr, r, lane, 2, 0, 0); continue; } r -= I_G;
        if (r < I_G) { tr_item(Wu, D_MODEL, FFN, w_gu, LDW, scr, r, lane, 2, 1, 0); continue; } r -= I_G;
        tr_item(Wd, FFN, D_MODEL, w_dn, LDWD, scr, r, lane, 0, 0, 0);
    }
}

__device__ __forceinline__ void row_norm_store(const f32x4 (&v)[8], const float* gain, bf16_t* orow, int lane) {
    float s = 0.f;
#pragma unroll
    for (int j = 0; j < 8; ++j) s += (v[j][0] * v[j][0] + v[j][1] * v[j][1]) + (v[j][2] * v[j][2] + v[j][3] * v[j][3]);
    const float rs = 1.0f / sqrtf(wave_sum(s) * (1.0f / D_MODEL) + EPS);
#pragma unroll
    for (int j = 0; j < 8; ++j) { const f32x4 gv = *(const f32x4*)(gain + 4 * lane + 256 * j); const f32x4 y = v[j] * rs * gv;
        u32x2 w; w.x = pk2(y[0], y[1]); w.y = pk2(y[2], y[3]); *(u32x2*)(orow + 4 * lane + 256 * j) = w; }
}
__device__ __forceinline__ void resid_rows(const float* prev, const bf16_t* Y, const float* ga, const bf16_t* F, const float* gc, float* xout, const float* gb, bf16_t* hn, int gw, int NGW, int lane) {
    for (int m = gw; m < MTOK; m += NGW) {
        f32x4 y[8]; float s = 0.f;
#pragma unroll
        for (int j = 0; j < 8; ++j) { const u32x2 w = *(const u32x2*)(Y + (size_t)m * LDH + 4 * lane + 256 * j); y[j] = (f32x4){bflo(w.x), bfhi(w.x), bflo(w.y), bfhi(w.y)};
            s += (y[j][0] * y[j][0] + y[j][1] * y[j][1]) + (y[j][2] * y[j][2] + y[j][3] * y[j][3]); }
        const float rs = 1.0f / sqrtf(wave_sum(s) * (1.0f / D_MODEL) + EPS);
        f32x4 x1[8];
#pragma unroll
        for (int j = 0; j < 8; ++j) { const f32x4 pv = *(const f32x4*)(prev + (size_t)m * D_MODEL + 4 * lane + 256 * j); const f32x4 gv = *(const f32x4*)(ga + 4 * lane + 256 * j);
            x1[j] = pv + y[j] * rs * gv; }
        if (F) {
            float s2 = 0.f;
#pragma unroll
            for (int j = 0; j < 8; ++j) { const u32x2 w = *(const u32x2*)(F + (size_t)m * LDH + 4 * lane + 256 * j); y[j] = (f32x4){bflo(w.x), bfhi(w.x), bflo(w.y), bfhi(w.y)};
                s2 += (y[j][0] * y[j][0] + y[j][1] * y[j][1]) + (y[j][2] * y[j][2] + y[j][3] * y[j][3]); }
            const float rs2 = 1.0f / sqrtf(wave_sum(s2) * (1.0f / D_MODEL) + EPS);
#pragma unroll
            for (int j = 0; j < 8; ++j) { const f32x4 gv = *(const f32x4*)(gc + 4 * lane + 256 * j); x1[j] = x1[j] + y[j] * rs2 * gv; }
        }
        if (xout) {
#pragma unroll
            for (int j = 0; j < 8; ++j) *(f32x4*)(xout + (size_t)m * D_MODEL + 4 * lane + 256 * j) = x1[j]; }
        if (hn) row_norm_store(x1, gb, hn + (size_t)m * LDH, lane);
    }
}

#define XB_TMO      128
#define XB_XCNT(j)  (256  + 64 * (j))
#define XB_XSUB(j)  (1280 + 64 * (j))
#define XB_XGEN(j)  (2304 + 64 * (j))
#define XB_TOP      3328
#define XB_TOPGEN   3392
#define XCD_BAR_WORDS 3456
#define XB_SPIN_CAP (1u << 18)
__device__ __forceinline__ unsigned xb_ld(unsigned* p)              { return __hip_atomic_load(p, __ATOMIC_RELAXED, __HIP_MEMORY_SCOPE_AGENT); }
__device__ __forceinline__ unsigned xb_add(unsigned* p, unsigned v) { return __hip_atomic_fetch_add(p, v, __ATOMIC_RELAXED, __HIP_MEMORY_SCOPE_AGENT); }
__device__ __forceinline__ unsigned xb_xcc_id() { return (unsigned)__builtin_amdgcn_s_getreg((3 << 11) | 20) & 0xFu; }
#define XB_SPIN(cond, bar) do { unsigned _sp = 0; while (cond) { __builtin_amdgcn_s_sleep(1); \
    if ((++_sp & 255u) == 0u) { if (xb_ld(&(bar)[XB_TMO])) break; if (_sp > XB_SPIN_CAP) { atomicAdd(&(bar)[XB_TMO], 1u); break; } } } } while (0)
struct XcdBarrier { unsigned* bar; unsigned x; volatile LAS unsigned* st; };
__device__ __forceinline__ XcdBarrier xcd_barrier_post(unsigned* bar, volatile LAS unsigned* st) {
    XcdBarrier b; b.bar = bar; b.x = xb_xcc_id(); b.st = st;
    if (threadIdx.x == 0) (void)xb_add(&bar[XB_XCNT(b.x)], 1u);
    return b;
}
__device__ __forceinline__ void xcd_barrier_complete(unsigned* bar, unsigned x, unsigned& nloc, unsigned& nx) {
    const unsigned G = gridDim.x * gridDim.y * gridDim.z;
    unsigned sum, cnt, mine, sp = 0u;
    for (;;) {
        sum = 0u; cnt = 0u; mine = 0u;
#pragma unroll
        for (unsigned j = 0; j < 16; ++j) { const unsigned c = xb_ld(&bar[XB_XCNT(j)]); sum += c; cnt += (c > 0u) ? 1u : 0u; mine = (j == x) ? c : mine; }
        if (sum == G) break;
        __builtin_amdgcn_s_sleep(1);
        if ((++sp & 255u) == 0u) { if (xb_ld(&bar[XB_TMO])) break; if (sp > XB_SPIN_CAP) { atomicAdd(&bar[XB_TMO], 1u); break; } }
    }
    nloc = mine > 0u ? mine : 1u; nx = cnt > 0u ? cnt : 1u;
}
__device__ __forceinline__ void xcd_barrier(const XcdBarrier& b) {
    asm volatile("s_waitcnt vmcnt(0)" ::: "memory");
    __syncthreads();
    if (threadIdx.x == 0) {
        unsigned* bar = b.bar;
        __builtin_amdgcn_s_waitcnt(0);
        unsigned nloc = b.st[0], nx = b.st[1];
        if (nloc == 0u) { xcd_barrier_complete(bar, b.x, nloc, nx); b.st[0] = nloc; b.st[1] = nx; }
        const unsigned old = xb_add(&bar[XB_XSUB(b.x)], 1u);
        const unsigned gen = old / nloc;
        if (old + 1u == (gen + 1u) * nloc) {
            __builtin_amdgcn_fence(__ATOMIC_RELEASE, "agent");
            asm volatile("s_waitcnt vmcnt(0)" ::: "memory");
            const unsigned og = xb_add(&bar[XB_TOP], 1u);
            const unsigned tg = og / nx;
            if (og + 1u == (tg + 1u) * nx) xb_add(&bar[XB_TOPGEN], 1u);
            else XB_SPIN(xb_ld(&bar[XB_TOPGEN]) == tg, bar);
            __builtin_amdgcn_fence(__ATOMIC_ACQUIRE, "agent");
            xb_add(&bar[XB_XGEN(b.x)], 1u);
            asm volatile("s_waitcnt vmcnt(0)" ::: "memory");
        } else {
            XB_SPIN(xb_ld(&bar[XB_XGEN(b.x)]) == gen, bar);
            __builtin_amdgcn_fence(__ATOMIC_ACQUIRE, "agent");
            asm volatile("s_waitcnt vmcnt(0)" ::: "memory");
        }
    }
    __syncthreads();
}

struct Ctx { int tid, lane, wid, G, bx, vcu, gw, NGW, gt, NGT; };
#define WSP(off) (a.ws + (off))
#define COS_T ((float*)WSP(WS_COS))
#define SIN_T ((float*)WSP(WS_SIN))
#define KMEAN ((float*)WSP(WS_KMEAN))
#define LSE ((float*)WSP(WS_LSE))
#define WB ((bf16_t*)WSP(WS_W))
#define YB ((bf16_t*)WSP(WS_A))
#define HN2B ((bf16_t*)WSP(WS_B))
#define HBUF ((bf16_t*)WSP(WS_H))
#define PROJ0 ((bf16_t*)WSP(WS_A))
#define PROJ1 ((bf16_t*)WSP(WS_B))
#define HN0 ((bf16_t*)a.out)
#define HN1 ((bf16_t*)WSP(WS_A))
#define MIX0 ((bf16_t*)a.out)
#define MIX1 ((bf16_t*)WSP(WS_MIX2))
#define POOLED ((bf16_t*)((unsigned char*)a.out + 72 * MiB))

__device__ __forceinline__ void p_prologue(const Args& a, LAS unsigned char* lds, const Ctx& c) {
    convert_weights(a, 0, lds, c.gw, c.NGW, c.wid, c.lane);
    float* cosT = COS_T; float* sinT = SIN_T; float* kmean = KMEAN;
    for (int i = c.gt; i < SEQ * 64; i += c.NGT) {
        const int t = i >> 6, e = i & 63; double pw = 1.0; for (int k = 0; k < e; ++k) pw *= 1.1547819846894583;
        const float inv = 1.0f / (float)pw; const double ang = (double)((float)t * inv);
        const double kq = rint(ang * 0.6366197723675814); const double r = (ang - kq * 1.5707963267948966) - kq * 6.123233995736766e-17; const double r2 = r * r;
        const double sn = r * (1.0 + r2 * (-1.0 / 6 + r2 * (1.0 / 120 + r2 * (-1.0 / 5040 + r2 * (1.0 / 362880 + r2 * (-1.0 / 39916800 + r2 * (1.0 / 6227020800.0)))))));
        const double cs = 1.0 + r2 * (-0.5 + r2 * (1.0 / 24 + r2 * (-1.0 / 720 + r2 * (1.0 / 40320 + r2 * (-1.0 / 3628800 + r2 * (1.0 / 479001600 + r2 * (-1.0 / 87178291200.0)))))));
        const int qd = ((int)kq) & 3; const double cc = (qd == 0) ? cs : (qd == 1) ? -sn : (qd == 2) ? -cs : sn; const double ss = (qd == 0) ? sn : (qd == 1) ? cs : (qd == 2) ? -sn : -cs;
        cosT[i] = (float)cc; sinT[i] = (float)ss; }
    for (int i = c.gt; i < BATCH * 8 * 16 * 128; i += c.NGT) kmean[i] = 0.f;
    for (int m = c.gw; m < MTOK; m += c.NGW) { f32x4 v[8];
#pragma unroll
        for (int j = 0; j < 8; ++j) v[j] = *(const f32x4*)(a.x + (size_t)m * D_MODEL + 4 * c.lane + 256 * j);
        row_norm_store(v, a.gains, HN0 + (size_t)m * LDH, c.lane); }
}
template <int L> __device__ __forceinline__ void p_inproj(const Args& a, LAS unsigned char* lds, const Ctx& c) {
    constexpr int ncol = L == 0 ? AB_IN : CD_IN, ldp = L == 0 ? LDP0 : LDP1;
    pg8::StaticOrder S; S.init(MTOK, ncol, c.G, c.bx);
    pg8::Gemm g{L == 0 ? HN0 : HN1, WB + W_IN / 2, LDH, LDW, D_MODEL, 0};
    pg8::Epi<1> E{L == 0 ? PROJ0 : PROJ1, ldp, nullptr, COS_T, SIN_T, L == 0 ? 1024 : 3072, L == 0 ? 7168 : 5120, L == 0 ? 0 : 4096, L == 0 ? 0 : 5120, KMEAN};
    pg8::gemm_phase<pg8::Epi<1>>(lds, g, S, E);
}
__device__ __forceinline__ void p_poolgemm(const Args& a, LAS unsigned char* lds, const Ctx& c) {
    pg8::StaticOrder S; S.init(MTOK, 1024, c.G, c.bx);
    pg8::Gemm g{POOLED, WB + W_POOL / 2, 1024, 256, 256, 256};
    pg8::Epi<0> E{MIX0, LDH, a.pool_scale, nullptr, nullptr, 0, 0, 0, 0, nullptr};
    pg8::gemm_phase<pg8::Epi<0>>(lds, g, S, E);
}
template <int L> __device__ __forceinline__ void p_outproj(const Args& a, LAS unsigned char* lds, const Ctx& c) {
    pg8::StaticOrder S; S.init(MTOK, D_MODEL, c.G, c.bx);
    pg8::Gemm g{L == 0 ? MIX0 : MIX1, WB + W_OUT / 2, LDH, LDW, D_MODEL, 0};
    pg8::Epi<0> E{YB, LDH, nullptr, nullptr, nullptr, 0, 0, 0, 0, nullptr};
    pg8::gemm_phase<pg8::Epi<0>>(lds, g, S, E);
}
__device__ __forceinline__ void p_gateup(const Args& a, LAS unsigned char* lds, const Ctx& c) {
    pg8::StaticOrder S; S.init(MTOK, 2 * FFN, c.G, c.bx);
    pg8::Gemm g{HN2B, WB + W_GU / 2, LDH, LDW, D_MODEL, 0};
    pg8::Epi<2> E{HBUF, LDHB, nullptr, nullptr, nullptr, 0, 0, 0, 0, nullptr};
    pg8::gemm_phase<pg8::Epi<2>>(lds, g, S, E);
}
__device__ __forceinline__ void p_down(const Args& a, LAS unsigned char* lds, const Ctx& c) {
    pg8::StaticOrder S; S.init(MTOK, D_MODEL, c.G, c.bx);
    pg8::Gemm g{HBUF, WB + W_DN / 2, LDHB, LDWD, FFN, 0};
    pg8::Epi<0> E{HN2B  , LDH, nullptr, nullptr, nullptr, 0, 0, 0, 0, nullptr};
    pg8::gemm_phase<pg8::Epi<0>>(lds, g, S, E);
}
__device__ __forceinline__ void p_dilated(const Args& a, LAS unsigned char* lds, const Ctx& c) {
    bf16_t* PROJ = PROJ0; float* lse = LSE;
    for (int idx = c.vcu; idx < 1536; idx += c.G) {
        const int gi = idx >> 9, rem = idx & 511, b = rem >> 7, h = (rem >> 4) & 7, sub = rem & 15;
        const int dil = gi == 0 ? 1 : (gi == 1 ? 4 : 16), nchunk = 16 / dil, r = sub / nchunk, chunk = sub % nchunk;
        const int q0 = 256 * chunk, kstart = chunk == 0 ? 0 : q0 - 128, ntiles = chunk == 0 ? 4 : 6;
        const int colq = 1024 + (gi * 8 + h) * 128;
        att::unit<att::DIL>(lds, PROJ + colq, PROJ + colq + 3072, PROJ + colq + 6144, PROJ + colq, LDP0, LDP0, b * SEQ + r, dil, q0, kstart, ntiles, lse + (size_t)gi * MTOK * 8 + h, 0);
    }
    for (int i = c.gt; i < MTOK * 128; i += c.NGT) {
        const int row = i >> 7, ch8 = i & 127, gi = ch8 >> 5, w = 2 << gi, t = row & (SEQ - 1), cnt = (t + 1 < w) ? t + 1 : w;
        float s[8], u0[8];
#pragma unroll
        for (int j = 0; j < 8; ++j) { s[j] = 0.f; u0[j] = 0.f; }
        for (int k = 0; k < cnt; ++k) { const u32x4 v = *(const u32x4*)(PROJ + (size_t)(row - k) * LDP0 + ch8 * 8);
            const float f[8] = {bflo(v.x), bfhi(v.x), bflo(v.y), bfhi(v.y), bflo(v.z), bfhi(v.z), bflo(v.w), bfhi(v.w)};
#pragma unroll
            for (int j = 0; j < 8; ++j) { s[j] += f[j]; u0[j] = (k == 0) ? f[j] : u0[j]; } }
        const float ic = 1.0f / (float)cnt; u32x4 o;
        o.x = pk2(s[0] * ic - u0[0], s[1] * ic - u0[1]); o.y = pk2(s[2] * ic - u0[2], s[3] * ic - u0[3]); o.z = pk2(s[4] * ic - u0[4], s[5] * ic - u0[5]); o.w = pk2(s[6] * ic - u0[6], s[7] * ic - u0[7]);
        *(u32x4*)(POOLED + (size_t)row * 1024 + ch8 * 8) = o; }
}
__device__ __forceinline__ void p_merge(const Args& a, const Ctx& c) {
    const bf16_t* PROJ = PROJ0; const float* lse = LSE; bf16_t* MIX = MIX0;
    for (int i = c.gt; i < MTOK * 128; i += c.NGT) {
        const int row = i >> 7, h = (i >> 4) & 7, cc = i & 15;
        const float l0 = lse[((size_t)0 * MTOK + row) * 8 + h], l1 = lse[((size_t)1 * MTOK + row) * 8 + h], l2 = lse[((size_t)2 * MTOK + row) * 8 + h];
        const float mx = fmaxf(l0, fmaxf(l1, l2)); float w0 = __expf(l0 - mx), w1 = __expf(l1 - mx), w2 = __expf(l2 - mx); const float iw = 1.0f / (w0 + w1 + w2); w0 *= iw; w1 *= iw; w2 *= iw;
        const bf16_t* base = PROJ + (size_t)row * LDP0 + 1024 + h * 128 + cc * 8;
        const u32x4 v0 = *(const u32x4*)base, v1 = *(const u32x4*)(base + 1024), v2 = *(const u32x4*)(base + 2048);
        u32x4 o;
        o.x = pk2(w0 * bflo(v0.x) + w1 * bflo(v1.x) + w2 * bflo(v2.x), w0 * bfhi(v0.x) + w1 * bfhi(v1.x) + w2 * bfhi(v2.x));
        o.y = pk2(w0 * bflo(v0.y) + w1 * bflo(v1.y) + w2 * bflo(v2.y), w0 * bfhi(v0.y) + w1 * bfhi(v1.y) + w2 * bfhi(v2.y));
        o.z = pk2(w0 * bflo(v0.z) + w1 * bflo(v1.z) + w2 * bflo(v2.z), w0 * bfhi(v0.z) + w1 * bfhi(v1.z) + w2 * bfhi(v2.z));
        o.w = pk2(w0 * bflo(v0.w) + w1 * bflo(v1.w) + w2 * bflo(v2.w), w0 * bfhi(v0.w) + w1 * bfhi(v1.w) + w2 * bfhi(v2.w));
        *(u32x4*)(MIX + (size_t)row * LDH + 1024 + h * 128 + cc * 8) = o; }
}
__device__ __forceinline__ void p_mix_cd(const Args& a, LAS unsigned char* lds, const Ctx& c) {
    bf16_t* PROJ = PROJ1; bf16_t* MIX = MIX1; const float* kmean = KMEAN;
    for (int v = c.vcu; v < 256; v += c.G) {
        const int b = v >> 6, h = (v >> 3) & 7, s = v & 7;
        for (int k = 0; k < 2; ++k) { const int qb = k == 0 ? 15 - s : s;
            att::unit<att::SB>(lds, PROJ + h * 128, PROJ + 1024 + h * 128, PROJ + 2048 + h * 128, MIX + h * 128, LDP1, LDH, b * SEQ, 1, 256 * qb, 0, 4 * (qb + 1), nullptr, 0); }
        for (int k = 0; k < 2; ++k) { const int qb = k == 0 ? 15 - s : s;
            att::moba_select(lds, PROJ + 3072 + h * 128, LDP1, b * SEQ, qb, kmean + (size_t)(b * 8 + h) * 16 * 128);
            att::unit<att::MOBA>(lds, PROJ + 3072 + h * 128, PROJ + 4096 + h * 128, PROJ + 5120 + h * 128, MIX + 1024 + h * 128, LDP1, LDH, b * SEQ, 1, 256 * qb, 0, 4 * (qb + 1), nullptr, qb); }
    }
}

__global__ void __launch_bounds__(512) hybrid_fwd(Args a) {
    extern __shared__ __attribute__((aligned(16))) unsigned char lds_raw[];
    LAS unsigned char* lds = (LAS unsigned char*)lds_raw;
    Ctx c;
    c.tid = threadIdx.x; c.lane = c.tid & 63; c.wid = __builtin_amdgcn_readfirstlane(c.tid >> 6);
    c.G = gridDim.x; c.bx = blockIdx.x;
    c.vcu = (c.G % 8 == 0) ? (c.bx % 8) * (c.G / 8) + c.bx / 8 : c.bx;
    c.gw = c.vcu * 8 + c.wid; c.NGW = c.G * 8; c.gt = c.bx * 512 + c.tid; c.NGT = c.G * 512;
    const int lo = a.ph_lo, hi = a.ph_hi;
    volatile LAS unsigned* xst = (volatile LAS unsigned*)(lds + LDS_BYTES - 64);
    if (c.tid < 2) xst[c.tid] = 0u;
    __syncthreads();
    XcdBarrier xb; xb.bar = (unsigned*)a.ws; xb.x = 0; xb.st = xst;
    if (hi - lo > 1) xb = xcd_barrier_post((unsigned*)a.ws, xst);
#define IN(k) (lo <= (k) && (k) < hi)
#define SEAM(k) do { if (IN(k) && IN((k) + 1)) xcd_barrier(xb); } while (0)
    if (IN(0)) p_prologue(a, lds, c);
    if (IN(0) && IN(1)) { cg::this_grid().sync(); }
    if (IN(1)) p_inproj<0>(a, lds, c);
    SEAM(1);
    if (IN(2)) p_dilated(a, lds, c);
    SEAM(2);
    if (IN(3)) { p_poolgemm(a, lds, c); p_merge(a, c); }
    SEAM(3);
    if (IN(4)) p_outproj<0>(a, lds, c);
    SEAM(4);
    if (IN(5)) resid_rows(a.x, YB, a.gains + D_MODEL, nullptr, nullptr, nullptr, a.gains + 2 * D_MODEL, HN2B, c.gw, c.NGW, c.lane);
    SEAM(5);
    if (IN(6)) p_gateup(a, lds, c);
    SEAM(6);
    if (IN(7)) p_down(a, lds, c);
    SEAM(7);
    if (IN(8)) { resid_rows(a.x, YB, a.gains + D_MODEL, HN2B, a.gains + 3 * D_MODEL, a.out, a.gains + 4 * D_MODEL, HN1  , c.gw, c.NGW, c.lane);
                 convert_weights(a, 1, lds, c.gw, c.NGW, c.wid, c.lane); }
    SEAM(8);
    if (IN(9)) p_inproj<1>(a, lds, c);
    SEAM(9);
    if (IN(10)) p_mix_cd(a, lds, c);
    SEAM(10);
    if (IN(11)) p_outproj<1>(a, lds, c);
    SEAM(11);
    if (IN(12)) resid_rows(a.out, YB, a.gains + 5 * D_MODEL, nullptr, nullptr, nullptr, a.gains + 6 * D_MODEL, HN2B, c.gw, c.NGW, c.lane);
    SEAM(12);
    if (IN(13)) p_gateup(a, lds, c);
    SEAM(13);
    if (IN(14)) p_down(a, lds, c);
    SEAM(14);
    if (IN(15)) resid_rows(a.out, YB, a.gains + 5 * D_MODEL, HN2B, a.gains + 7 * D_MODEL, a.out, nullptr, nullptr, c.gw, c.NGW, c.lane);
#undef IN
#undef SEAM
}

extern "C" void kernel_launch(void* const* d_in, const int* in_sizes, int n_in, void* d_out, int out_size, void* d_ws, size_t ws_size, hipStream_t stream) {
    static int grid = 0;
    if (grid == 0) {
        if (n_in != 11 || in_sizes[0] != MTOK * D_MODEL || out_size != MTOK * D_MODEL || ws_size < WS_END) { fprintf(stderr, "kernel_launch: unexpected shapes / workspace (n_in %d, ws %zu)\n", n_in, ws_size); grid = -1; return; }
        int dev = 0, cus = 0, per_cu = 0;
        if (hipGetDevice(&dev) != hipSuccess || hipDeviceGetAttribute(&cus, hipDeviceAttributeMultiprocessorCount, dev) != hipSuccess) { grid = -1; return; }
        if (hipFuncSetAttribute((const void*)hybrid_fwd, hipFuncAttributeMaxDynamicSharedMemorySize, LDS_BYTES) != hipSuccess) { fprintf(stderr, "kernel_launch: hipFuncSetAttribute failed\n"); grid = -1; return; }
        if (hipOccupancyMaxActiveBlocksPerMultiprocessor(&per_cu, (const void*)hybrid_fwd, 512, LDS_BYTES) != hipSuccess || per_cu < 1) { fprintf(stderr, "kernel_launch: occupancy query says %d\n", per_cu); per_cu = 1; }
        (void)hipGetLastError();
        grid = cus;
    }
    if (grid < 0) return;
    Args a{};
    a.x = (const float*)d_in[0]; a.gains = (const float*)d_in[1]; a.w_in_ab = (const float*)d_in[2]; a.pool_w = (const float*)d_in[3]; a.pool_scale = (const float*)d_in[4];
    a.w_out_ab = (const float*)d_in[5]; a.w_in_cd = (const float*)d_in[6]; a.w_out_cd = (const float*)d_in[7]; a.ffn_gate = (const float*)d_in[8]; a.ffn_up = (const float*)d_in[9]; a.ffn_down = (const float*)d_in[10];
    a.out = (float*)d_out; a.ws = (unsigned char*)d_ws;
#if MK_ONE_LAUNCH
    if (hipMemsetAsync(d_ws, 0, 16384, stream) != hipSuccess) { fprintf(stderr, "kernel_launch: memset failed\n"); return; }
    a.ph_lo = 0; a.ph_hi = 16;
    void* args[] = {&a};
    hipError_t e = hipLaunchCooperativeKernel((const void*)hybrid_fwd, dim3(grid), dim3(512), args, LDS_BYTES, stream);
    if (e != hipSuccess) fprintf(stderr, "cooperative launch failed: %s (grid %d)\n", hipGetErrorString(e), grid);
#else
    for (int ph = 0; ph < MK_NPH; ++ph) for (int rep = 0; rep < ((((MK_REP) >> ph) & 1) ? 2 : 1); ++rep) { a.ph_lo = ph; a.ph_hi = ph + 1; hipLaunchKernelGGL(hybrid_fwd, dim3(grid), dim3(512), LDS_BYTES, stream, a); }
#endif
}
```

```cpp
#include <hip/hip_runtime.h>
#include <hip/hip_cooperative_groups.h>
#include <cstdio>
namespace cg = cooperative_groups;

#ifndef MK_ONE_LAUNCH
#define MK_ONE_LAUNCH 1
#endif
#ifndef MK_NPH
#define MK_NPH 16
#endif
#ifndef MK_REP
#define MK_REP 0
#endif

#define LAS __attribute__((address_space(3)))
typedef unsigned short bf16_t;
typedef short bf16x8 __attribute__((ext_vector_type(8)));
typedef short s16x4 __attribute__((ext_vector_type(4)));
typedef float f32x4 __attribute__((ext_vector_type(4)));
typedef unsigned u32x4 __attribute__((ext_vector_type(4)));
typedef unsigned u32x2 __attribute__((ext_vector_type(2)));

constexpr int D_MODEL = 2048, BATCH = 4, SEQ = 4096, MTOK = BATCH * SEQ;
constexpr int AB_IN = 10240, CD_IN = 6144, FFN = 5632;
constexpr float EPS = 1e-6f;
constexpr size_t MiB = 1u << 20;
constexpr size_t WS_COS = 1 * MiB, WS_SIN = 2 * MiB, WS_KMEAN = 3 * MiB, WS_LSE = 4 * MiB;
constexpr int LDH = D_MODEL + 64, LDW = D_MODEL + 64, LDWD = FFN + 64, LDHB = FFN + 64, LDP0 = AB_IN + 64, LDP1 = CD_IN + 64;
constexpr size_t WS_W = 8 * MiB;
constexpr size_t W_IN = 0, W_POOL = (size_t)AB_IN * LDW * 2, W_OUT = W_POOL + 524288, W_GU = W_OUT + (size_t)D_MODEL * LDW * 2, W_DN = W_GU + (size_t)2 * FFN * LDW * 2, W_ENDB = W_DN + (size_t)D_MODEL * LDWD * 2;
static_assert(W_ENDB <= 120 * MiB, "weight region");
constexpr size_t WS_A = 128 * MiB;
constexpr size_t WS_B = 196 * MiB;
constexpr size_t WS_H = 264 * MiB;
constexpr size_t WS_MIX2 = 392 * MiB;
constexpr size_t WS_END = 460 * MiB;
static_assert((size_t)MTOK * LDP0 * 2 <= WS_END - WS_A && (size_t)MTOK * LDH * 2 <= 68 * MiB && WS_B + (size_t)MTOK * LDP1 * 2 <= WS_MIX2 && WS_H + (size_t)MTOK * LDHB * 2 <= WS_END && WS_MIX2 + (size_t)MTOK * LDH * 2 <= WS_END, "d_ws map");
constexpr int LDS_BYTES = 144 * 1024;

__device__ __forceinline__ unsigned f2bf(float f) { unsigned u = __builtin_bit_cast(unsigned, f); return (u + 0x7fffu + ((u >> 16) & 1u)) >> 16; }
__device__ __forceinline__ unsigned pk2(float lo, float hi) { unsigned r; asm("v_cvt_pk_bf16_f32 %0, %1, %2" : "=v"(r) : "v"(lo), "v"(hi)); return r; }
__device__ __forceinline__ float bflo(unsigned w) { return __builtin_bit_cast(float, w << 16); }
__device__ __forceinline__ float bfhi(unsigned w) { return __builtin_bit_cast(float, w & 0xffff0000u); }
__device__ __forceinline__ float wave_sum(float v) {
#pragma unroll
    for (int o = 1; o < 64; o <<= 1) v += __shfl_xor(v, o);
    return v;
}

namespace pg8 {
constexpr int BM = 256, BK = 64, HALF = 128, HTB = HALF * BK * 2, STAGE_BYTES = 8 * HTB, NXCD = 8, WGM = 8;
__host__ __device__ __forceinline__ int lds_byte(int r, int c) { const int st = (r >> 4) * 2 + (c >> 5), rr = r & 15, cc = c & 31, ob = rr * 64 + cc * 2; return st * 1024 + (ob ^ (((ob >> 9) & 1) << 5)); }
__host__ __device__ __forceinline__ void stage_rc(int b, int& R, int& C) { const int st = b / 1024, sb = b % 1024, swz = sb ^ (((sb >> 9) & 1) << 5); R = (st >> 1) * 16 + swz / 64; C = (st & 1) * 32 + (swz % 64) / 2; }
__host__ __device__ __forceinline__ int perm32(int rho) { const int n = rho >> 4, i = rho & 15; return 8 * (i >> 2) + 4 * n + (i & 3); }

struct Unit { int pm, pn; };
struct Gemm { const bf16_t* A; const bf16_t* Bt; int lda, ldb, K, a_koff; };

struct StaticOrder {
    int nM, nN, nwg, G, c;
    __device__ void init(int M, int N, int G_, int c_) { nM = M / BM; nN = N / BM; nwg = nM * nN; G = G_; c = c_; }
    __device__ bool next(int i, Unit& u) const {
        const long L = (long)i * G + c; if (L >= nwg) return false;
        int wgid = (int)L; { const int q = nwg / NXCD, r = nwg % NXCD, xcd = wgid % NXCD, off = wgid / NXCD; wgid = (xcd < r ? xcd * (q + 1) : r * (q + 1) + (xcd - r) * q) + off; }
        const int nig = WGM * nN, gid = wgid / nig, fm = gid * WGM, gsz = (nM - fm) < WGM ? (nM - fm) : WGM;
        u.pm = fm + ((wgid % nig) % gsz); u.pn = (wgid % nig) / gsz; return true;
    }
};

__device__ __forceinline__ unsigned cvt_pk_bf16(float lo, float hi) { unsigned r; asm volatile("v_cvt_pk_bf16_f32 %0, %1, %2" : "=v"(r) : "v"(lo), "v"(hi)); return r; }

template <int MODE> struct Epi {
    bf16_t* O; int ldc;
    const float* colscale;
    const float* cosT; const float* sinT; int rope_lo, rope_hi, km_lo, km_hi; float* kmean;
    __device__ __forceinline__ void operator()(const f32x4 (&acc)[2][2][4][2], const Unit& u, int wr, int wc, int fr, int fq) const {
        const int row0 = u.pm * BM + wr * 64 + fr, colt = u.pn * BM, cin = wc * 32 + 8 * fq;
        if constexpr (MODE == 2) {
            const int col0 = u.pn * 128 + wc * 32 + 8 * fq;
#pragma unroll
            for (int ai = 0; ai < 2; ++ai)
#pragma unroll
                for (int m = 0; m < 4; ++m) { bf16_t* rowp = O + (size_t)(row0 + ai * HALF + m * 16) * ldc + col0; float h[2][4];
#pragma unroll
                    for (int bj = 0; bj < 2; ++bj) { const f32x4 g = acc[ai][bj][m][0], up = acc[ai][bj][m][1];
#pragma unroll
                        for (int j = 0; j < 4; ++j) h[bj][j] = g[j] * __builtin_amdgcn_rcpf(1.0f + __builtin_amdgcn_exp2f(-1.4426950408889634f * g[j])) * up[j]; }
                    u32x4 w; w.x = cvt_pk_bf16(h[0][0], h[0][1]); w.y = cvt_pk_bf16(h[0][2], h[0][3]); w.z = cvt_pk_bf16(h[1][0], h[1][1]); w.w = cvt_pk_bf16(h[1][2], h[1][3]);
                    *(u32x4*)rowp = w; }
            return;
        }
        bool rope = false, km = false;
        if constexpr (MODE == 1) { rope = (colt >= rope_lo && colt < rope_hi); km = (colt >= km_lo && colt < km_hi); }
        if constexpr (MODE == 0) {
            const int colo = colt + 64 * wc + 8 * fq; const bool low = fr < 8;
            f32x4 sc[2][2];
#pragma unroll
            for (int bj = 0; bj < 2; ++bj)
#pragma unroll
                for (int n = 0; n < 2; ++n) sc[bj][n] = colscale ? *(const f32x4*)(colscale + colo + 32 * bj + 4 * n) : (f32x4){1.f, 1.f, 1.f, 1.f};
#pragma unroll
            for (int ai = 0; ai < 2; ++ai)
#pragma unroll
                for (int m = 0; m < 4; ++m) {
                    u32x4 w[2];
#pragma unroll
                    for (int bj = 0; bj < 2; ++bj) { const f32x4 v0 = acc[ai][bj][m][0] * sc[bj][0], v1 = acc[ai][bj][m][1] * sc[bj][1];
                        w[bj].x = cvt_pk_bf16(v0[0], v0[1]); w[bj].y = cvt_pk_bf16(v0[2], v0[3]); w[bj].z = cvt_pk_bf16(v1[0], v1[1]); w[bj].w = cvt_pk_bf16(v1[2], v1[3]); }
                    u32x4 snd, rcv;
                    snd.x = low ? w[1].x : w[0].x; snd.y = low ? w[1].y : w[0].y; snd.z = low ? w[1].z : w[0].z; snd.w = low ? w[1].w : w[0].w;
                    rcv.x = (unsigned)__shfl_xor((int)snd.x, 8); rcv.y = (unsigned)__shfl_xor((int)snd.y, 8); rcv.z = (unsigned)__shfl_xor((int)snd.z, 8); rcv.w = (unsigned)__shfl_xor((int)snd.w, 8);
                    u32x4 dA, dB;
                    dA.x = low ? w[0].x : rcv.x; dA.y = low ? w[0].y : rcv.y; dA.z = low ? w[0].z : rcv.z; dA.w = low ? w[0].w : rcv.w;
                    dB.x = low ? rcv.x : w[1].x; dB.y = low ? rcv.y : w[1].y; dB.z = low ? rcv.z : w[1].z; dB.w = low ? rcv.w : w[1].w;
                    bf16_t* pA = O + (size_t)(u.pm * BM + wr * 64 + ai * HALF + m * 16 + (fr & 7)) * ldc + colo + (low ? 0 : 32);
                    __builtin_nontemporal_store(dA, (u32x4*)pA); __builtin_nontemporal_store(dB, (u32x4*)(pA + (size_t)8 * ldc)); }
            return;
        }
        if (!rope) {
#pragma unroll
            for (int ai = 0; ai < 2; ++ai)
#pragma unroll
                for (int m = 0; m < 4; ++m) { bf16_t* rowp = O + (size_t)(row0 + ai * HALF + m * 16) * ldc + colt + cin;
#pragma unroll
                    for (int bj = 0; bj < 2; ++bj) { const f32x4 v0 = acc[ai][bj][m][0], v1 = acc[ai][bj][m][1];
                        u32x4 w; w.x = cvt_pk_bf16(v0[0], v0[1]); w.y = cvt_pk_bf16(v0[2], v0[3]); w.z = cvt_pk_bf16(v1[0], v1[1]); w.w = cvt_pk_bf16(v1[2], v1[3]);
                        *(u32x4*)(rowp + bj * HALF) = w; } }
            return;
        }
        if constexpr (MODE == 1) {
            const int e0 = 16 * wc + 4 * fq;
            f32x4 ks[2][2];
#pragma unroll
            for (int bj = 0; bj < 2; ++bj) { ks[bj][0] = (f32x4){0.f, 0.f, 0.f, 0.f}; ks[bj][1] = (f32x4){0.f, 0.f, 0.f, 0.f}; }
#pragma unroll
            for (int ai = 0; ai < 2; ++ai)
#pragma unroll
                for (int m = 0; m < 4; ++m) { const int row = row0 + ai * HALF + m * 16, t = row & (SEQ - 1);
                    const f32x4 c4 = *(const f32x4*)(cosT + t * 64 + e0), s4 = *(const f32x4*)(sinT + t * 64 + e0);
                    bf16_t* rowp = O + (size_t)row * ldc + colt + cin;
#pragma unroll
                    for (int bj = 0; bj < 2; ++bj) { const f32x4 x1 = acc[ai][bj][m][0], x2 = acc[ai][bj][m][1];
                        const f32x4 o1 = x1 * c4 - x2 * s4, o2 = x2 * c4 + x1 * s4;
                        ks[bj][0] += o1; ks[bj][1] += o2;
                        u32x4 w; w.x = cvt_pk_bf16(o1[0], o1[1]); w.y = cvt_pk_bf16(o1[2], o1[3]); w.z = cvt_pk_bf16(o2[0], o2[1]); w.w = cvt_pk_bf16(o2[2], o2[3]);
                        *(u32x4*)(rowp + bj * HALF) = w; } }
            if (km) {
                const int b = u.pm >> 4, blk = u.pm & 15;
#pragma unroll
                for (int bj = 0; bj < 2; ++bj) { const int h = (colt + bj * HALF - km_lo) >> 7;
#pragma unroll
                    for (int n = 0; n < 2; ++n)
#pragma unroll
                        for (int j = 0; j < 4; ++j) { float v = ks[bj][n][j];
                            v += __shfl_xor(v, 1); v += __shfl_xor(v, 2); v += __shfl_xor(v, 4); v += __shfl_xor(v, 8);
                            if (fr == 0) atomicAdd(kmean + ((size_t)((b * 8 + h) * 16 + blk)) * 128 + cin + 4 * n + j, v * (1.0f / 256.0f)); } }
            }
        }
    }
};

template <class EpiT>
__device__ __forceinline__ void gemm_phase(LAS unsigned char* lds, const Gemm g, const StaticOrder& S, const EpiT& E) {
    const int tid = threadIdx.x, wid = __builtin_amdgcn_readfirstlane(tid >> 6), lane = tid & 63, wr = wid >> 2, wc = wid & 3, fr = lane & 15, fq = lane >> 4;
    const int K = g.K, nt = K / BK;
    unsigned voffA[2], voffB[2];
#pragma unroll
    for (int i = 0; i < 2; ++i) { int R, C; stage_rc(tid * 16 + i * 8192, R, C); const int Rb = (R & ~31) + perm32(R & 31);
        voffA[i] = (unsigned)(R * g.lda + C) * 2u; voffB[i] = (unsigned)(Rb * g.ldb + C) * 2u; }
    const size_t kstep = (size_t)(BK * 2);
    const size_t hstepA = (size_t)HALF * g.lda * 2, hstepB = (size_t)HALF * g.ldb * 2;
    const size_t tstepA = 2 * hstepA, tstepB = 2 * hstepB;
    const unsigned ldsw = (unsigned)wid * 1024u;
    const int aoff = lds_byte(wr * 64 + fr, fq * 8), boff = lds_byte(wc * 32 + fr, fq * 8);
#define PG8_SA(b, h) (((b) * 2 + (h)) * HTB)
#define PG8_SB(b, h) ((4 + (b) * 2 + (h)) * HTB)
#define PG8_STAGE(bufoff, gbase, voff) do { _Pragma("unroll") for (int _i = 0; _i < 2; ++_i) \
        __builtin_amdgcn_global_load_lds((const unsigned*)((const char*)(gbase) + (voff)[_i]), (LAS unsigned*)(lds + (bufoff) + ldsw + _i * 8192), 16, 0, 0); } while (0)
#define PG8_LDA(dst, b, h) do { _Pragma("unroll") for (int m = 0; m < 4; ++m) _Pragma("unroll") for (int k = 0; k < 2; ++k) dst[m][k] = *(const LAS bf16x8*)(lds + PG8_SA(b, h) + aoff + m * 2048 + k * 1024); } while (0)
#define PG8_LDB(dst, b, h) do { _Pragma("unroll") for (int n = 0; n < 2; ++n) _Pragma("unroll") for (int k = 0; k < 2; ++k) dst[n][k] = *(const LAS bf16x8*)(lds + PG8_SB(b, h) + boff + n * 2048 + k * 1024); } while (0)
#define PG8_MMA(ai, bj, At, Bt) do { __builtin_amdgcn_s_setprio(1); _Pragma("unroll") for (int m = 0; m < 4; ++m) _Pragma("unroll") for (int n = 0; n < 2; ++n) _Pragma("unroll") for (int k = 0; k < 2; ++k) \
        acc[ai][bj][m][n] = __builtin_amdgcn_mfma_f32_16x16x32_bf16(Bt[n][k], At[m][k], acc[ai][bj][m][n], 0, 0, 0); __builtin_amdgcn_s_setprio(0); } while (0)
#define PG8_WAIT_V(n) asm volatile("s_waitcnt vmcnt(" #n ")" ::: "memory")
#define PG8_WAIT_L(n) asm volatile("s_waitcnt lgkmcnt(" #n ")" ::: "memory")
#define PG8_BAR __builtin_amdgcn_s_barrier()
#define PG8_SCHED __builtin_amdgcn_sched_barrier(0)
    Unit cur, nxt; int ui = 0;
    if (!S.next(0, cur)) return;
    f32x4 acc[2][2][4][2];
#pragma unroll
    for (int a = 0; a < 2; ++a)
#pragma unroll
        for (int b = 0; b < 2; ++b)
#pragma unroll
            for (int m = 0; m < 4; ++m)
#pragma unroll
                for (int n = 0; n < 2; ++n) acc[a][b][m][n] = (f32x4){0.f, 0.f, 0.f, 0.f};
    bf16x8 At[4][2], B0[2][2], B1[2][2];
    const char* cA = (const char*)g.A + (size_t)cur.pm * tstepA + (size_t)cur.pn * g.a_koff * 2; const char* cB = (const char*)g.Bt + (size_t)cur.pn * tstepB;
    PG8_STAGE(PG8_SB(0, 0), cB, voffB); PG8_STAGE(PG8_SB(0, 1), cB + hstepB, voffB); PG8_STAGE(PG8_SA(0, 0), cA, voffA); PG8_STAGE(PG8_SA(0, 1), cA + hstepA, voffA);
    if (wr == 1) PG8_BAR;
    PG8_WAIT_V(2); PG8_BAR;
    PG8_STAGE(PG8_SB(1, 0), cB + kstep, voffB); PG8_STAGE(PG8_SA(1, 0), cA + kstep, voffA); PG8_STAGE(PG8_SB(1, 1), cB + hstepB + kstep, voffB);
    PG8_WAIT_V(6); PG8_BAR;
    for (;;) {
        const bool has_next = S.next(ui + 1, nxt);
        const char* nA = has_next ? (const char*)g.A + (size_t)nxt.pm * tstepA + (size_t)nxt.pn * g.a_koff * 2 : cA; const char* nB = has_next ? (const char*)g.Bt + (size_t)nxt.pn * tstepB : cB;
        for (int t = 0; t < nt; t += 2) {
            const bool last = (t == nt - 2);
            const char* a1 = cA + (size_t)(t + 1) * kstep;
            const char* a2 = last ? nA : cA + (size_t)(t + 2) * kstep; const char* b2 = last ? nB : cB + (size_t)(t + 2) * kstep;
            const char* a3 = a2 + kstep; const char* b3 = b2 + kstep;
            PG8_LDB(B0, 0, 0); PG8_LDB(B1, 0, 1); PG8_SCHED; PG8_LDA(At, 0, 0); PG8_STAGE(PG8_SA(1, 1), a1 + hstepA, voffA);
            PG8_WAIT_V(8); PG8_WAIT_L(0); PG8_BAR; PG8_MMA(0, 0, At, B0); PG8_MMA(0, 1, At, B1); PG8_BAR; PG8_SCHED;
            PG8_LDA(At, 0, 1); PG8_STAGE(PG8_SB(0, 0), b2, voffB); PG8_STAGE(PG8_SB(0, 1), b2 + hstepB, voffB); PG8_STAGE(PG8_SA(0, 0), a2, voffA);
            PG8_WAIT_V(8); PG8_WAIT_L(0); PG8_BAR; PG8_MMA(1, 0, At, B0); PG8_MMA(1, 1, At, B1); PG8_BAR; PG8_SCHED;
            PG8_LDB(B0, 1, 0); PG8_LDB(B1, 1, 1); PG8_SCHED; PG8_LDA(At, 1, 0); PG8_STAGE(PG8_SA(0, 1), a2 + hstepA, voffA);
            PG8_WAIT_V(8); PG8_WAIT_L(0); PG8_BAR; PG8_MMA(0, 0, At, B0); PG8_MMA(0, 1, At, B1); PG8_BAR; PG8_SCHED;
            PG8_LDA(At, 1, 1); PG8_STAGE(PG8_SB(1, 0), b3, voffB); PG8_STAGE(PG8_SB(1, 1), b3 + hstepB, voffB); PG8_STAGE(PG8_SA(1, 0), a3, voffA);
            PG8_WAIT_V(8); PG8_WAIT_L(0); PG8_BAR; PG8_MMA(1, 0, At, B0); PG8_MMA(1, 1, At, B1); PG8_BAR; PG8_SCHED;
        }
        if (wr == 0) PG8_BAR;
        E(acc, cur, wr, wc, fr, fq);
        if (!has_next) break;
#pragma unroll
        for (int a = 0; a < 2; ++a)
#pragma unroll
            for (int b = 0; b < 2; ++b)
#pragma unroll
                for (int m = 0; m < 4; ++m)
#pragma unroll
                    for (int n = 0; n < 2; ++n) acc[a][b][m][n] = (f32x4){0.f, 0.f, 0.f, 0.f};
        cur = nxt; cA = nA; cB = nB; ++ui;
        if (wr == 1) PG8_BAR;
    }
    PG8_WAIT_V(0);
    PG8_BAR;
#undef PG8_SA
#undef PG8_SB
#undef PG8_STAGE
#undef PG8_LDA
#undef PG8_LDB
#undef PG8_MMA
#undef PG8_WAIT_V
#undef PG8_WAIT_L
#undef PG8_BAR
#undef PG8_SCHED
}
}

namespace att {
constexpr int ROWB = 288, KOFF = 0, VOFF = 64 * ROWB, BUFB = 2 * 64 * ROWB, KM_OFF = 3 * BUFB, GATE_OFF = KM_OFF + 8192, SEL_OFF = GATE_OFF + 16384, DONE_OFF = SEL_OFF + 1024;
enum { DIL = 0, SB = 1, MOBA = 2 };
constexpr float SCALE = 0.08838834764831845f, LOG2E = 1.4426950408889634f, SCL2 = SCALE * LOG2E;
#define MFMA16(a, b, c) __builtin_amdgcn_mfma_f32_16x16x32_bf16((a), (b), (c), 0, 0, 0)

template <int MODE>
__device__ __forceinline__ void unit(LAS unsigned char* lds, const bf16_t* Qp, const bf16_t* Kp, const bf16_t* Vp, bf16_t* Op, int ld, int ldo, int rowbase, int rowstride,
                                     int q0, int kstart, int ntiles, float* lse_out, int ob) {
    int tid_ = threadIdx.x; asm volatile("" : "+v"(tid_));
    const int tid = tid_, lane = tid & 63, wid = __builtin_amdgcn_readfirstlane(tid >> 6), c15 = lane & 15, g = lane >> 4;
    const int qw0 = q0 + 32 * wid;
    const bool hiw = wid >= 4;
    bf16x8 qf[2][4];
#pragma unroll
    for (int qt = 0; qt < 2; ++qt) { const int qrow = rowbase + (qw0 + 16 * qt + c15) * rowstride;
#pragma unroll
        for (int ks = 0; ks < 4; ++ks) qf[qt][ks] = *(const bf16x8*)(Qp + (size_t)qrow * ld + 32 * ks + 8 * g); }
    f32x4 o[2][8];
#pragma unroll
    for (int qt = 0; qt < 2; ++qt)
#pragma unroll
        for (int dt = 0; dt < 8; ++dt) o[qt][dt] = (f32x4){0.f, 0.f, 0.f, 0.f};
    float mrun[2] = {-1e30f, -1e30f}, lrun[2] = {0.f, 0.f}, Rrun[2] = {1.f, 1.f};
    const int srow = tid >> 4, sch = tid & 15;
    u32x4 kr[2], vr[2];
#define ATT_LOAD(kp0_) do { _Pragma("unroll") for (int _i = 0; _i < 2; ++_i) { const int _grow = rowbase + ((kp0_) + srow + 32 * _i) * rowstride; \
        kr[_i] = *(const u32x4*)(Kp + (size_t)_grow * ld + sch * 8); vr[_i] = *(const u32x4*)(Vp + (size_t)_grow * ld + sch * 8); } } while (0)
#define ATT_KP0(i_) ((MODE == SB) ? (kstart + 64 * (ntiles - 1 - (i_))) : (kstart + 64 * (i_)))
#define ATT_PV(tb_) do { _Pragma("unroll") for (int st = 0; st < 2; ++st) { __builtin_amdgcn_sched_barrier(0); \
        const LAS unsigned char* vb = (tb_) + VOFF + (32 * st + 4 * g + (c15 >> 2)) * ROWB + (c15 & 3) * 8; \
        _Pragma("unroll") for (int dt = 0; dt < 8; ++dt) { \
            const s16x4 a0 = __builtin_amdgcn_ds_read_tr16_b64_v4i16((LAS s16x4*)(vb + dt * 32)); \
            const s16x4 a1 = __builtin_amdgcn_ds_read_tr16_b64_v4i16((LAS s16x4*)(vb + 16 * ROWB + dt * 32)); \
            const bf16x8 vf = __builtin_shufflevector(a0, a1, 0, 1, 2, 3, 4, 5, 6, 7); \
            _Pragma("unroll") for (int qt = 0; qt < 2; ++qt) o[qt][dt] = MFMA16(vf, pf[qt][st], o[qt][dt]); } } } while (0)
    bf16x8 pf[2][2]; bool pend = false; int bcur = 0, bprev = 0;
    ATT_LOAD(ATT_KP0(0));
#pragma unroll
    for (int i = 0; i < 2; ++i) { *(LAS u32x4*)(lds + KOFF + (srow + 32 * i) * ROWB + sch * 16) = kr[i]; *(LAS u32x4*)(lds + VOFF + (srow + 32 * i) * ROWB + sch * 16) = vr[i]; }
    __syncthreads();
    for (int it = 0; it < ntiles; ++it) {
        if constexpr (MODE == SB) { if (it > 0) {
            const u32x4 d0 = *(const LAS u32x4*)(lds + DONE_OFF + ((it - 1) & 1) * 32), d1 = *(const LAS u32x4*)(lds + DONE_OFF + ((it - 1) & 1) * 32 + 16);
            if ((d0.x & d0.y & d0.z & d0.w & d1.x & d1.y & d1.z & d1.w) != 0u) break; } }
        if (it + 1 < ntiles) ATT_LOAD(ATT_KP0(it + 1));
        LAS unsigned char* const tb = lds + bcur * BUFB;
        if (hiw && pend) { ATT_PV(lds + bprev * BUFB); pend = false; }
        const int kp0 = ATT_KP0(it);
        bool active; bool own = false; int bjk = 0;
        unsigned selq[2] = {0u, 0u};
        if constexpr (MODE == MOBA) { selq[0] = ((const LAS unsigned*)(lds + SEL_OFF))[32 * wid + c15]; selq[1] = ((const LAS unsigned*)(lds + SEL_OFF))[32 * wid + 16 + c15]; }
        if constexpr (MODE == DIL) active = !((kp0 > qw0 + 31) || (kp0 + 63 < qw0 - 128));
        else if constexpr (MODE == SB) active = (kp0 < qw0 + 31) && __any((Rrun[0] != 0.f) || (Rrun[1] != 0.f));
        else { own = (kp0 >= q0); bjk = kp0 >> 8; active = own ? (kp0 <= qw0 + 31) : (__any((int)(((selq[0] | selq[1]) >> bjk) & 1u)) != 0); }
        if (active) {
            f32x4 s[2][4];
#pragma unroll
            for (int qt = 0; qt < 2; ++qt)
#pragma unroll
                for (int kt = 0; kt < 4; ++kt) s[qt][kt] = (f32x4){0.f, 0.f, 0.f, 0.f};
            const LAS unsigned char* kb = tb + KOFF + c15 * ROWB + g * 16;
#pragma unroll
            for (int ks = 0; ks < 4; ++ks) {
#pragma unroll
                for (int kt = 0; kt < 4; ++kt) { const bf16x8 kf = *(const LAS bf16x8*)(kb + kt * 16 * ROWB + ks * 64);
#pragma unroll
                    for (int qt = 0; qt < 2; ++qt) s[qt][kt] = MFMA16(kf, qf[qt][ks], s[qt][kt]); }
            }
#pragma unroll
            for (int qt = 0; qt < 2; ++qt) {
                const int qp = qw0 + 16 * qt + c15;
                float p[4][4];
                if constexpr (MODE == SB) {
                    float bp[4][4], E[4], tot[4];
#pragma unroll
                    for (int kt = 0; kt < 4; ++kt) { float r[4], beta[4];
#pragma unroll
                        for (int j = 0; j < 4; ++j) { const int kp = kp0 + 16 * kt + 4 * g + j;
                            float z = s[qt][kt][j] * SCALE; z = fminf(fmaxf(z, -80.f), 80.f);
                            const float en = __builtin_amdgcn_exp2f(-LOG2E * z); const float b = __builtin_amdgcn_rcpf(1.0f + en); const float rr = en * b;
                            const bool valid = kp < qp; beta[j] = valid ? b : 0.f; r[j] = valid ? rr : 1.f; }
                        const float P1 = r[3] * r[2], P0 = P1 * r[1];
                        bp[kt][3] = beta[3]; bp[kt][2] = beta[2] * r[3]; bp[kt][1] = beta[1] * P1; bp[kt][0] = beta[0] * P0;
                        const float T = P0 * r[0];
                        const float Tx = __shfl_xor(T, 16), pair = T * Tx, U = __shfl_xor(pair, 32);
                        E[kt] = (g == 0) ? Tx * U : (g == 1) ? U : (g == 2) ? Tx : 1.0f; tot[kt] = pair * U; }
                    float R = Rrun[qt];
#pragma unroll
                    for (int kk = 0; kk < 4; ++kk) { const int kt = 3 - kk; const float base = E[kt] * R;
#pragma unroll
                        for (int j = 0; j < 4; ++j) p[kt][j] = bp[kt][j] * base;
                        R *= tot[kt]; }
                    Rrun[qt] = R;
                } else {
                    bool umask, lv = true;
                    if constexpr (MODE == DIL) umask = (kp0 >= qw0 - 97) && (kp0 + 63 <= qw0);
                    else { umask = own ? (kp0 + 63 <= qw0) : true; lv = own ? true : (((selq[qt] >> bjk) & 1u) != 0u); }
                    float mx, alpha, mnew, rs = 0.f;
                    if (umask) {
                        float mxr = s[qt][0][0];
#pragma unroll
                        for (int kt = 0; kt < 4; ++kt)
#pragma unroll
                            for (int j = 0; j < 4; ++j) mxr = fmaxf(mxr, s[qt][kt][j]);
                        mx = lv ? mxr * SCL2 : -1e30f;
                        mx = fmaxf(mx, __shfl_xor(mx, 16)); mx = fmaxf(mx, __shfl_xor(mx, 32));
                        mnew = fmaxf(mrun[qt], mx); alpha = __builtin_amdgcn_exp2f(mrun[qt] - mnew); mrun[qt] = mnew;
                        const float cc = lv ? -mnew : -3e30f;
#pragma unroll
                        for (int kt = 0; kt < 4; ++kt)
#pragma unroll
                            for (int j = 0; j < 4; ++j) { p[kt][j] = __builtin_amdgcn_exp2f(__builtin_fmaf(s[qt][kt][j], SCL2, cc)); rs += p[kt][j]; }
                    } else {
                        mx = -1e30f;
#pragma unroll
                        for (int kt = 0; kt < 4; ++kt)
#pragma unroll
                            for (int j = 0; j < 4; ++j) { const int kp = kp0 + 16 * kt + 4 * g + j; bool valid;
                                if constexpr (MODE == DIL) valid = (kp <= qp) && (qp - kp <= 128);
                                else valid = own ? (kp <= qp) : (((selq[qt] >> bjk) & 1u) != 0u);
                                p[kt][j] = valid ? s[qt][kt][j] * SCL2 : -1e30f; mx = fmaxf(mx, p[kt][j]); }
                        mx = fmaxf(mx, __shfl_xor(mx, 16)); mx = fmaxf(mx, __shfl_xor(mx, 32));
                        mnew = fmaxf(mrun[qt], mx); alpha = __builtin_amdgcn_exp2f(mrun[qt] - mnew); mrun[qt] = mnew;
#pragma unroll
                        for (int kt = 0; kt < 4; ++kt)
#pragma unroll
                            for (int j = 0; j < 4; ++j) { p[kt][j] = __builtin_amdgcn_exp2f(p[kt][j] - mnew); rs += p[kt][j]; }
                    }
                    rs += __shfl_xor(rs, 16); rs += __shfl_xor(rs, 32);
                    lrun[qt] = lrun[qt] * alpha + rs;
                    if (__any(alpha != 1.0f)) {
#pragma unroll
                        for (int dt = 0; dt < 8; ++dt) o[qt][dt] *= alpha; }
                }
#pragma unroll
                for (int st = 0; st < 2; ++st) { u32x4 w; w.x = pk2(p[2 * st][0], p[2 * st][1]); w.y = pk2(p[2 * st][2], p[2 * st][3]); w.z = pk2(p[2 * st + 1][0], p[2 * st + 1][1]); w.w = pk2(p[2 * st + 1][2], p[2 * st + 1][3]);
                    pf[qt][st] = __builtin_bit_cast(bf16x8, w); }
            }
            if (hiw) pend = true; else ATT_PV(tb);
        }
        if (it + 1 < ntiles) {
            LAS unsigned char* const nb = lds + (bcur == 2 ? 0 : bcur + 1) * BUFB;
#pragma unroll
            for (int i = 0; i < 2; ++i) { *(LAS u32x4*)(nb + KOFF + (srow + 32 * i) * ROWB + sch * 16) = kr[i]; *(LAS u32x4*)(nb + VOFF + (srow + 32 * i) * ROWB + sch * 16) = vr[i]; }
        }
        if constexpr (MODE == SB) { if (lane == 0) ((LAS unsigned*)(lds + DONE_OFF + (it & 1) * 32))[wid] = __any((Rrun[0] != 0.f) || (Rrun[1] != 0.f)) ? 0u : 1u; }
        __syncthreads();
        bprev = bcur; bcur = bcur == 2 ? 0 : bcur + 1;
    }
    if (hiw && pend) ATT_PV(lds + bprev * BUFB);
    __syncthreads();
#undef ATT_PV
#undef ATT_LOAD
#undef ATT_KP0
#pragma unroll
    for (int qt = 0; qt < 2; ++qt) {
        const int orow = rowbase + (qw0 + 16 * qt + c15) * rowstride;
        const float inv = (MODE == SB) ? 1.0f : 1.0f / lrun[qt];
#pragma unroll
        for (int dt = 0; dt < 8; ++dt) { const f32x4 v = o[qt][dt] * inv; u32x2 w; w.x = pk2(v[0], v[1]); w.y = pk2(v[2], v[3]);
            *(u32x2*)(Op + (size_t)orow * ldo + 16 * dt + 4 * g) = w; }
        if constexpr (MODE == DIL) { if (g == 0) lse_out[(size_t)orow * 8] = (mrun[qt] + __builtin_amdgcn_logf(lrun[qt])) * 0.6931471805599453f; }
    }
}

__device__ __forceinline__ void moba_select(LAS unsigned char* lds, const bf16_t* Qp, int ld, int rowbase, int ob, const float* kmean_bh) {
    const int tid = threadIdx.x;
    LAS float* km_s = (LAS float*)(lds + KM_OFF); LAS float* gate_s = (LAS float*)(lds + GATE_OFF); LAS unsigned* sel_s = (LAS unsigned*)(lds + SEL_OFF);
    __syncthreads();
    ((LAS f32x4*)km_s)[tid] = ((const f32x4*)kmean_bh)[tid];
    __syncthreads();
    { const int q = tid >> 1, par = tid & 1; const bf16_t* qrow = Qp + (size_t)(rowbase + ob * 256 + q) * ld;
      float acc[8];
#pragma unroll
      for (int jj = 0; jj < 8; ++jj) acc[jj] = 0.f;
      for (int c = 0; c < 16; ++c) {
          const u32x4 qv = *(const u32x4*)(qrow + c * 8);
          float qfv[8]; qfv[0] = bflo(qv.x); qfv[1] = bfhi(qv.x); qfv[2] = bflo(qv.y); qfv[3] = bfhi(qv.y); qfv[4] = bflo(qv.z); qfv[5] = bfhi(qv.z); qfv[6] = bflo(qv.w); qfv[7] = bfhi(qv.w);
#pragma unroll
          for (int jj = 0; jj < 8; ++jj) { const int j = 2 * jj + par;
              if (j < ob) { const LAS float* km = km_s + j * 128 + c * 8; const f32x4 ka = *(const LAS f32x4*)km, kb = *(const LAS f32x4*)(km + 4);
                  acc[jj] += qfv[0] * ka[0] + qfv[1] * ka[1] + qfv[2] * ka[2] + qfv[3] * ka[3] + qfv[4] * kb[0] + qfv[5] * kb[1] + qfv[6] * kb[2] + qfv[7] * kb[3]; } }
      }
#pragma unroll
      for (int jj = 0; jj < 8; ++jj) gate_s[q * 16 + 2 * jj + par] = acc[jj]; }
    __syncthreads();
    if (tid < 256) {
        float gq[16];
#pragma unroll
        for (int j4 = 0; j4 < 4; ++j4) { const f32x4 v = *(const LAS f32x4*)(gate_s + tid * 16 + 4 * j4); gq[4 * j4] = v[0]; gq[4 * j4 + 1] = v[1]; gq[4 * j4 + 2] = v[2]; gq[4 * j4 + 3] = v[3]; }
        unsigned sel = 0u;
#pragma unroll
        for (int pick = 0; pick < 3; ++pick) { float best = -3.0e38f; int bi = -1;
#pragma unroll
            for (int j = 0; j < 16; ++j) { const bool ok = (j < ob) && (((sel >> j) & 1u) == 0u) && (gq[j] > best); best = ok ? gq[j] : best; bi = ok ? j : bi; }
            if (bi >= 0) sel |= 1u << bi; }
        sel_s[tid] = sel;
    }
    __syncthreads();
}
}

__device__ __forceinline__ int il128(int e) { return 8 * ((e & 63) >> 2) + 4 * (e >> 6) + (e & 3); }
__device__ __forceinline__ void tr_item(const float* W, int K, int N, bf16_t* WT, int ldt, LAS float* scr, int item, int lane, int mapmode, int p0, int p1) {
    const int nblk = N / 32, kb = item / nblk, nb = item % nblk, k0 = 64 * kb, n0 = 32 * nb;
#pragma unroll 8
    for (int i = 0; i < 32; ++i) { const int kk = 2 * i + (lane >> 5); scr[kk * 33 + (lane & 31)] = W[(size_t)(k0 + kk) * N + n0 + (lane & 31)]; }
    asm volatile("s_waitcnt lgkmcnt(0)" ::: "memory");
    const int c = lane & 7;
#pragma unroll
    for (int j = 0; j < 4; ++j) { const int n = (lane >> 3) + 8 * j; const LAS float* s = scr + (8 * c) * 33 + n;
        u32x4 o; o.x = pk2(s[0 * 33], s[1 * 33]); o.y = pk2(s[2 * 33], s[3 * 33]); o.z = pk2(s[4 * 33], s[5 * 33]); o.w = pk2(s[6 * 33], s[7 * 33]);
        const int ns = n0 + n; int dst;
        if (mapmode == 0) dst = p0 + (ns & ~255) + 128 * ((ns >> 5) & 1) + 32 * ((ns >> 6) & 3) + (ns & 31);
        else if (mapmode == 1) dst = (ns >= p0 && ns < p1) ? ((ns & ~127) + il128(ns & 127)) : ns;
        else dst = 256 * (ns >> 7) + 128 * ((ns >> 2) & 1) + 32 * ((ns >> 5) & 3) + 8 * ((ns >> 3) & 3) + 4 * p0 + (ns & 3);
        *(u32x4*)(WT + (size_t)dst * ldt + k0 + 8 * c) = o; }
    asm volatile("s_waitcnt lgkmcnt(0)" ::: "memory");
}

struct Args { const float* x; const float* gains; const float* w_in_ab; const float* pool_w; const float* pool_scale; const float* w_out_ab; const float* w_in_cd; const float* w_out_cd;
              const float* ffn_gate; const float* ffn_up; const float* ffn_down; float* out; unsigned char* ws; int ph_lo, ph_hi; };

__device__ __forceinline__ void convert_weights(const Args& a, int layer, LAS unsigned char* lds, int gw, int NGW, int wid, int lane) {
    LAS float* scr = (LAS float*)(lds + wid * 16384);
    bf16_t* wb = (bf16_t*)(a.ws + WS_W);
    bf16_t* w_in = wb + W_IN / 2; bf16_t* w_pool = wb + W_POOL / 2; bf16_t* w_out = wb + W_OUT / 2; bf16_t* w_gu = wb + W_GU / 2; bf16_t* w_dn = wb + W_DN / 2;
    const int NIN = layer == 0 ? AB_IN : CD_IN;
    const int I_IN = 32 * (NIN / 32), I_POOL = layer == 0 ? 4 * 4 * 8 : 0, I_OUT = 32 * 64, I_G = 32 * (FFN / 32), I_D = (FFN / 64) * 64;
    const int NIT = I_IN + I_POOL + I_OUT + 2 * I_G + I_D;
    const float* Win = layer == 0 ? a.w_in_ab : a.w_in_cd; const float* Wout = layer == 0 ? a.w_out_ab : a.w_out_cd;
    const int rlo = layer == 0 ? 1024 : 3072, rhi = layer == 0 ? 7168 : 5120;
    const float* Wg = a.ffn_gate + (size_t)layer * D_MODEL * FFN; const float* Wu = a.ffn_up + (size_t)layer * D_MODEL * FFN; const float* Wd = a.ffn_down + (size_t)layer * D_MODEL * FFN;
    for (int it = gw; it < NIT; it += NGW) {
        int r = it;
        if (r < I_IN) { tr_item(Win, D_MODEL, NIN, w_in, LDW, scr, r, lane, 1, rlo, rhi); continue; } r -= I_IN;
        if (r < I_POOL) { const int gi = r >> 5; tr_item(a.pool_w + gi * 65536, 256, 256, w_pool, 256, scr, r & 31, lane, 0, gi * 256, 0); continue; } r -= I_POOL;
        if (r < I_OUT) { tr_item(Wout, D_MODEL, D_MODEL, w_out, LDW, scr, r, lane, 0, 0, 0); continue; } r -= I_OUT;
        if (r < I_G) { tr_item(Wg, D_MODEL, FFN, w_gu, LDW, scr, r, lane, 2, 0, 0); continue; } r -= I_G;
        if (r < I_G) { tr_item(Wu, D_MODEL, FFN, w_gu, LDW, scr, r, lane, 2, 1, 0); continue; } r -= I_G;
        tr_item(Wd, FFN, D_MODEL, w_dn, LDWD, scr, r, lane, 0, 0, 0);
    }
}

__device__ __forceinline__ void row_norm_store(const f32x4 (&v)[8], const float* gain, bf16_t* orow, int lane) {
    float s = 0.f;
#pragma unroll
    for (int j = 0; j < 8; ++j) s += (v[j][0] * v[j][0] + v[j][1] * v[j][1]) + (v[j][2] * v[j][2] + v[j][3] * v[j][3]);
    const float rs = 1.0f / sqrtf(wave_sum(s) * (1.0f / D_MODEL) + EPS);
#pragma unroll
    for (int j = 0; j < 8; ++j) { const f32x4 gv = *(const f32x4*)(gain + 4 * lane + 256 * j); const f32x4 y = v[j] * rs * gv;
        u32x2 w; w.x = pk2(y[0], y[1]); w.y = pk2(y[2], y[3]); *(u32x2*)(orow + 4 * lane + 256 * j) = w; }
}
__device__ __forceinline__ void resid_rows(const float* prev, const bf16_t* Y, const float* ga, const bf16_t* F, const float* gc, float* xout, const float* gb, bf16_t* hn, int gw, int NGW, int lane) {
    for (int m = gw; m < MTOK; m += NGW) {
        f32x4 y[8]; float s = 0.f;
#pragma unroll
        for (int j = 0; j < 8; ++j) { const u32x2 w = *(const u32x2*)(Y + (size_t)m * LDH + 4 * lane + 256 * j); y[j] = (f32x4){bflo(w.x), bfhi(w.x), bflo(w.y), bfhi(w.y)};
            s += (y[j][0] * y[j][0] + y[j][1] * y[j][1]) + (y[j][2] * y[j][2] + y[j][3] * y[j][3]); }
        const float rs = 1.0f / sqrtf(wave_sum(s) * (1.0f / D_MODEL) + EPS);
        f32x4 x1[8];
#pragma unroll
        for (int j = 0; j < 8; ++j) { const f32x4 pv = *(const f32x4*)(prev + (size_t)m * D_MODEL + 4 * lane + 256 * j); const f32x4 gv = *(const f32x4*)(ga + 4 * lane + 256 * j);
            x1[j] = pv + y[j] * rs * gv; }
        if (F) {
            float s2 = 0.f;
#pragma unroll
            for (int j = 0; j < 8; ++j) { const u32x2 w = *(const u32x2*)(F + (size_t)m * LDH + 4 * lane + 256 * j); y[j] = (f32x4){bflo(w.x), bfhi(w.x), bflo(w.y), bfhi(w.y)};
                s2 += (y[j][0] * y[j][0] + y[j][1] * y[j][1]) + (y[j][2] * y[j][2] + y[j][3] * y[j][3]); }
            const float rs2 = 1.0f / sqrtf(wave_sum(s2) * (1.0f / D_MODEL) + EPS);
#pragma unroll
            for (int j = 0; j < 8; ++j) { const f32x4 gv = *(const f32x4*)(gc + 4 * lane + 256 * j); x1[j] = x1[j] + y[j] * rs2 * gv; }
        }
        if (xout) {
#pragma unroll
            for (int j = 0; j < 8; ++j) __builtin_nontemporal_store(x1[j], (f32x4*)(xout + (size_t)m * D_MODEL + 4 * lane + 256 * j)); }
        if (hn) row_norm_store(x1, gb, hn + (size_t)m * LDH, lane);
    }
}

#define XB_TMO      128
#define XB_XCNT(j)  (256  + 64 * (j))
#define XB_XSUB(j)  (1280 + 64 * (j))
#define XB_XGEN(j)  (2304 + 64 * (j))
#define XB_TOP      3328
#define XB_TOPGEN   3392
#define XCD_BAR_WORDS 3456
#define XB_SPIN_CAP (1u << 18)
__device__ __forceinline__ unsigned xb_ld(unsigned* p)              { return __hip_atomic_load(p, __ATOMIC_RELAXED, __HIP_MEMORY_SCOPE_AGENT); }
__device__ __forceinline__ unsigned xb_add(unsigned* p, unsigned v) { return __hip_atomic_fetch_add(p, v, __ATOMIC_RELAXED, __HIP_MEMORY_SCOPE_AGENT); }
__device__ __forceinline__ unsigned xb_xcc_id() { return (unsigned)__builtin_amdgcn_s_getreg((3 << 11) | 20) & 0xFu; }
#define XB_SPIN(cond, bar) do { unsigned _sp = 0; while (cond) { __builtin_amdgcn_s_sleep(1); \
    if ((++_sp & 255u) == 0u) { if (xb_ld(&(bar)[XB_TMO])) break; if (_sp > XB_SPIN_CAP) { atomicAdd(&(bar)[XB_TMO], 1u); break; } } } } while (0)
struct XcdBarrier { unsigned* bar; unsigned x; volatile LAS unsigned* st; };
__device__ __forceinline__ XcdBarrier xcd_barrier_post(unsigned* bar, volatile LAS unsigned* st) {
    XcdBarrier b; b.bar = bar; b.x = xb_xcc_id(); b.st = st;
    if (threadIdx.x == 0) (void)xb_add(&bar[XB_XCNT(b.x)], 1u);
    return b;
}
__device__ __forceinline__ void xcd_barrier_complete(unsigned* bar, unsigned x, unsigned& nloc, unsigned& nx) {
    const unsigned G = gridDim.x * gridDim.y * gridDim.z;
    unsigned sum, cnt, mine, sp = 0u;
    for (;;) {
        sum = 0u; cnt = 0u; mine = 0u;
#pragma unroll
        for (unsigned j = 0; j < 16; ++j) { const unsigned c = xb_ld(&bar[XB_XCNT(j)]); sum += c; cnt += (c > 0u) ? 1u : 0u; mine = (j == x) ? c : mine; }
        if (sum == G) break;
        __builtin_amdgcn_s_sleep(1);
        if ((++sp & 255u) == 0u) { if (xb_ld(&bar[XB_TMO])) break; if (sp > XB_SPIN_CAP) { atomicAdd(&bar[XB_TMO], 1u); break; } }
    }
    nloc = mine > 0u ? mine : 1u; nx = cnt > 0u ? cnt : 1u;
}
__device__ __forceinline__ void xcd_barrier(const XcdBarrier& b) {
    asm volatile("s_waitcnt vmcnt(0)" ::: "memory");
    __syncthreads();
    if (threadIdx.x == 0) {
        unsigned* bar = b.bar;
        __builtin_amdgcn_s_waitcnt(0);
        unsigned nloc = b.st[0], nx = b.st[1];
        if (nloc == 0u) { xcd_barrier_complete(bar, b.x, nloc, nx); b.st[0] = nloc; b.st[1] = nx; }
        const unsigned old = xb_add(&bar[XB_XSUB(b.x)], 1u);
        const unsigned gen = old / nloc;
        if (old + 1u == (gen + 1u) * nloc) {
            __builtin_amdgcn_fence(__ATOMIC_RELEASE, "agent");
            asm volatile("s_waitcnt vmcnt(0)" ::: "memory");
            const unsigned og = xb_add(&bar[XB_TOP], 1u);
            const unsigned tg = og / nx;
            if (og + 1u == (tg + 1u) * nx) xb_add(&bar[XB_TOPGEN], 1u);
            else XB_SPIN(xb_ld(&bar[XB_TOPGEN]) == tg, bar);
            __builtin_amdgcn_fence(__ATOMIC_ACQUIRE, "agent");
            xb_add(&bar[XB_XGEN(b.x)], 1u);
            asm volatile("s_waitcnt vmcnt(0)" ::: "memory");
        } else {
            XB_SPIN(xb_ld(&bar[XB_XGEN(b.x)]) == gen, bar);
            __builtin_amdgcn_fence(__ATOMIC_ACQUIRE, "agent");
            asm volatile("s_waitcnt vmcnt(0)" ::: "memory");
        }
    }
    __syncthreads();
}

struct Ctx { int tid, lane, wid, G, bx, vcu, gw, NGW, gt, NGT; };
#define WSP(off) (a.ws + (off))
#define COS_T ((float*)WSP(WS_COS))
#define SIN_T ((float*)WSP(WS_SIN))
#define KMEAN ((float*)WSP(WS_KMEAN))
#define LSE ((float*)WSP(WS_LSE))
#define WB ((bf16_t*)WSP(WS_W))
#define YB ((bf16_t*)WSP(WS_A))
#define HN2B ((bf16_t*)WSP(WS_B))
#define HBUF ((bf16_t*)WSP(WS_H))
#define PROJ0 ((bf16_t*)WSP(WS_A))
#define PROJ1 ((bf16_t*)WSP(WS_B))
#define HN0 ((bf16_t*)a.out)
#define HN1 ((bf16_t*)WSP(WS_A))
#define MIX0 ((bf16_t*)a.out)
#define MIX1 ((bf16_t*)WSP(WS_MIX2))
#define POOLED ((bf16_t*)((unsigned char*)a.out + 72 * MiB))

__device__ __forceinline__ void p_prologue(const Args& a, LAS unsigned char* lds, const Ctx& c) {
    convert_weights(a, 0, lds, c.gw, c.NGW, c.wid, c.lane);
    float* cosT = COS_T; float* sinT = SIN_T; float* kmean = KMEAN;
    for (int i = c.gt; i < SEQ * 64; i += c.NGT) {
        const int t = i >> 6, e = i & 63; double pw = 1.0; for (int k = 0; k < e; ++k) pw *= 1.1547819846894583;
        const float inv = 1.0f / (float)pw; const double ang = (double)((float)t * inv);
        const double kq = rint(ang * 0.6366197723675814); const double r = (ang - kq * 1.5707963267948966) - kq * 6.123233995736766e-17; const double r2 = r * r;
        const double sn = r * (1.0 + r2 * (-1.0 / 6 + r2 * (1.0 / 120 + r2 * (-1.0 / 5040 + r2 * (1.0 / 362880 + r2 * (-1.0 / 39916800 + r2 * (1.0 / 6227020800.0)))))));
        const double cs = 1.0 + r2 * (-0.5 + r2 * (1.0 / 24 + r2 * (-1.0 / 720 + r2 * (1.0 / 40320 + r2 * (-1.0 / 3628800 + r2 * (1.0 / 479001600 + r2 * (-1.0 / 87178291200.0)))))));
        const int qd = ((int)kq) & 3; const double cc = (qd == 0) ? cs : (qd == 1) ? -sn : (qd == 2) ? -cs : sn; const double ss = (qd == 0) ? sn : (qd == 1) ? cs : (qd == 2) ? -sn : -cs;
        cosT[i] = (float)cc; sinT[i] = (float)ss; }
    for (int i = c.gt; i < BATCH * 8 * 16 * 128; i += c.NGT) kmean[i] = 0.f;
    for (int m = c.gw; m < MTOK; m += c.NGW) { f32x4 v[8];
#pragma unroll
        for (int j = 0; j < 8; ++j) v[j] = *(const f32x4*)(a.x + (size_t)m * D_MODEL + 4 * c.lane + 256 * j);
        row_norm_store(v, a.gains, HN0 + (size_t)m * LDH, c.lane); }
}
template <int L> __device__ __forceinline__ void p_inproj(const Args& a, LAS unsigned char* lds, const Ctx& c) {
    constexpr int ncol = L == 0 ? AB_IN : CD_IN, ldp = L == 0 ? LDP0 : LDP1;
    pg8::StaticOrder S; S.init(MTOK, ncol, c.G, c.bx);
    pg8::Gemm g{L == 0 ? HN0 : HN1, WB + W_IN / 2, LDH, LDW, D_MODEL, 0};
    pg8::Epi<1> E{L == 0 ? PROJ0 : PROJ1, ldp, nullptr, COS_T, SIN_T, L == 0 ? 1024 : 3072, L == 0 ? 7168 : 5120, L == 0 ? 0 : 4096, L == 0 ? 0 : 5120, KMEAN};
    pg8::gemm_phase<pg8::Epi<1>>(lds, g, S, E);
}
__device__ __forceinline__ void p_poolgemm(const Args& a, LAS unsigned char* lds, const Ctx& c) {
    pg8::StaticOrder S; S.init(MTOK, 1024, c.G, c.bx);
    pg8::Gemm g{POOLED, WB + W_POOL / 2, 1024, 256, 256, 256};
    pg8::Epi<0> E{MIX0, LDH, a.pool_scale, nullptr, nullptr, 0, 0, 0, 0, nullptr};
    pg8::gemm_phase<pg8::Epi<0>>(lds, g, S, E);
}
template <int L> __device__ __forceinline__ void p_outproj(const Args& a, LAS unsigned char* lds, const Ctx& c) {
    pg8::StaticOrder S; S.init(MTOK, D_MODEL, c.G, c.bx);
    pg8::Gemm g{L == 0 ? MIX0 : MIX1, WB + W_OUT / 2, LDH, LDW, D_MODEL, 0};
    pg8::Epi<0> E{YB, LDH, nullptr, nullptr, nullptr, 0, 0, 0, 0, nullptr};
    pg8::gemm_phase<pg8::Epi<0>>(lds, g, S, E);
}
__device__ __forceinline__ void p_gateup(const Args& a, LAS unsigned char* lds, const Ctx& c) {
    pg8::StaticOrder S; S.init(MTOK, 2 * FFN, c.G, c.bx);
    pg8::Gemm g{HN2B, WB + W_GU / 2, LDH, LDW, D_MODEL, 0};
    pg8::Epi<2> E{HBUF, LDHB, nullptr, nullptr, nullptr, 0, 0, 0, 0, nullptr};
    pg8::gemm_phase<pg8::Epi<2>>(lds, g, S, E);
}
__device__ __forceinline__ void p_down(const Args& a, LAS unsigned char* lds, const Ctx& c) {
    pg8::StaticOrder S; S.init(MTOK, D_MODEL, c.G, c.bx);
    pg8::Gemm g{HBUF, WB + W_DN / 2, LDHB, LDWD, FFN, 0};
    pg8::Epi<0> E{HN2B  , LDH, nullptr, nullptr, nullptr, 0, 0, 0, 0, nullptr};
    pg8::gemm_phase<pg8::Epi<0>>(lds, g, S, E);
}
__device__ __forceinline__ void p_dilated(const Args& a, LAS unsigned char* lds, const Ctx& c) {
    bf16_t* PROJ = PROJ0; float* lse = LSE;
    for (int idx = c.vcu; idx < 1536; idx += c.G) {
        const int gi = idx >> 9, rem = idx & 511, b = rem >> 7, h = (rem >> 4) & 7, sub = rem & 15;
        const int dil = gi == 0 ? 1 : (gi == 1 ? 4 : 16), nchunk = 16 / dil, r = sub / nchunk, chunk = sub % nchunk;
        const int q0 = 256 * chunk, kstart = chunk == 0 ? 0 : q0 - 128, ntiles = chunk == 0 ? 4 : 6;
        const int colq = 1024 + (gi * 8 + h) * 128;
        att::unit<att::DIL>(lds, PROJ + colq, PROJ + colq + 3072, PROJ + colq + 6144, PROJ + colq, LDP0, LDP0, b * SEQ + r, dil, q0, kstart, ntiles, lse + (size_t)gi * MTOK * 8 + h, 0);
    }
    for (int i = c.gt; i < MTOK * 128; i += c.NGT) {
        const int row = i >> 7, ch8 = i & 127, gi = ch8 >> 5, w = 2 << gi, t = row & (SEQ - 1), cnt = (t + 1 < w) ? t + 1 : w;
        float s[8], u0[8];
#pragma unroll
        for (int j = 0; j < 8; ++j) { s[j] = 0.f; u0[j] = 0.f; }
        for (int k = 0; k < cnt; ++k) { const u32x4 v = *(const u32x4*)(PROJ + (size_t)(row - k) * LDP0 + ch8 * 8);
            const float f[8] = {bflo(v.x), bfhi(v.x), bflo(v.y), bfhi(v.y), bflo(v.z), bfhi(v.z), bflo(v.w), bfhi(v.w)};
#pragma unroll
            for (int j = 0; j < 8; ++j) { s[j] += f[j]; u0[j] = (k == 0) ? f[j] : u0[j]; } }
        const float ic = 1.0f / (float)cnt; u32x4 o;
        o.x = pk2(s[0] * ic - u0[0], s[1] * ic - u0[1]); o.y = pk2(s[2] * ic - u0[2], s[3] * ic - u0[3]); o.z = pk2(s[4] * ic - u0[4], s[5] * ic - u0[5]); o.w = pk2(s[6] * ic - u0[6], s[7] * ic - u0[7]);
        *(u32x4*)(POOLED + (size_t)row * 1024 + ch8 * 8) = o; }
}
__device__ __forceinline__ void p_merge(const Args& a, const Ctx& c) {
    const bf16_t* PROJ = PROJ0; const float* lse = LSE; bf16_t* MIX = MIX0;
    for (int i = c.gt; i < MTOK * 128; i += c.NGT) {
        const int row = i >> 7, h = (i >> 4) & 7, cc = i & 15;
        const float l0 = lse[((size_t)0 * MTOK + row) * 8 + h], l1 = lse[((size_t)1 * MTOK + row) * 8 + h], l2 = lse[((size_t)2 * MTOK + row) * 8 + h];
        const float mx = fmaxf(l0, fmaxf(l1, l2)); float w0 = __expf(l0 - mx), w1 = __expf(l1 - mx), w2 = __expf(l2 - mx); const float iw = 1.0f / (w0 + w1 + w2); w0 *= iw; w1 *= iw; w2 *= iw;
        const bf16_t* base = PROJ + (size_t)row * LDP0 + 1024 + h * 128 + cc * 8;
        const u32x4 v0 = *(const u32x4*)base, v1 = *(const u32x4*)(base + 1024), v2 = *(const u32x4*)(base + 2048);
        u32x4 o;
        o.x = pk2(w0 * bflo(v0.x) + w1 * bflo(v1.x) + w2 * bflo(v2.x), w0 * bfhi(v0.x) + w1 * bfhi(v1.x) + w2 * bfhi(v2.x));
        o.y = pk2(w0 * bflo(v0.y) + w1 * bflo(v1.y) + w2 * bflo(v2.y), w0 * bfhi(v0.y) + w1 * bfhi(v1.y) + w2 * bfhi(v2.y));
        o.z = pk2(w0 * bflo(v0.z) + w1 * bflo(v1.z) + w2 * bflo(v2.z), w0 * bfhi(v0.z) + w1 * bfhi(v1.z) + w2 * bfhi(v2.z));
        o.w = pk2(w0 * bflo(v0.w) + w1 * bflo(v1.w) + w2 * bflo(v2.w), w0 * bfhi(v0.w) + w1 * bfhi(v1.w) + w2 * bfhi(v2.w));
        *(u32x4*)(MIX + (size_t)row * LDH + 1024 + h * 128 + cc * 8) = o; }
}
__device__ __forceinline__ void p_mix_cd(const Args& a, LAS unsigned char* lds, const Ctx& c) {
    bf16_t* PROJ = PROJ1; bf16_t* MIX = MIX1; const float* kmean = KMEAN;
    for (int v = c.vcu; v < 256; v += c.G) {
        const int b = v >> 6, h = (v >> 3) & 7, s = v & 7;
        for (int k = 0; k < 2; ++k) { const int qb = k == 0 ? 15 - s : s;
            att::unit<att::SB>(lds, PROJ + h * 128, PROJ + 1024 + h * 128, PROJ + 2048 + h * 128, MIX + h * 128, LDP1, LDH, b * SEQ, 1, 256 * qb, 0, 4 * (qb + 1), nullptr, 0); }
        for (int k = 0; k < 2; ++k) { const int qb = k == 0 ? 15 - s : s;
            att::moba_select(lds, PROJ + 3072 + h * 128, LDP1, b * SEQ, qb, kmean + (size_t)(b * 8 + h) * 16 * 128);
            att::unit<att::MOBA>(lds, PROJ + 3072 + h * 128, PROJ + 4096 + h * 128, PROJ + 5120 + h * 128, MIX + 1024 + h * 128, LDP1, LDH, b * SEQ, 1, 256 * qb, 0, 4 * (qb + 1), nullptr, qb); }
    }
}

__global__ void __launch_bounds__(512) hybrid_fwd(Args a) {
    extern __shared__ __attribute__((aligned(16))) unsigned char lds_raw[];
    LAS unsigned char* lds = (LAS unsigned char*)lds_raw;
    Ctx c;
    c.tid = threadIdx.x; c.lane = c.tid & 63; c.wid = __builtin_amdgcn_readfirstlane(c.tid >> 6);
    c.G = gridDim.x; c.bx = blockIdx.x;
    c.vcu = (c.G % 8 == 0) ? (c.bx % 8) * (c.G / 8) + c.bx / 8 : c.bx;
    c.gw = c.vcu * 8 + c.wid; c.NGW = c.G * 8; c.gt = c.bx * 512 + c.tid; c.NGT = c.G * 512;
    const int lo = a.ph_lo, hi = a.ph_hi;
    volatile LAS unsigned* xst = (volatile LAS unsigned*)(lds + LDS_BYTES - 64);
    if (c.tid < 2) xst[c.tid] = 0u;
    __syncthreads();
    XcdBarrier xb; xb.bar = (unsigned*)a.ws; xb.x = 0; xb.st = xst;
    if (hi - lo > 1) xb = xcd_barrier_post((unsigned*)a.ws, xst);
#define IN(k) (lo <= (k) && (k) < hi)
#define SEAM(k) do { if (IN(k) && IN((k) + 1)) xcd_barrier(xb); } while (0)
    if (IN(0)) p_prologue(a, lds, c);
    if (IN(0) && IN(1)) { cg::this_grid().sync(); }
    if (IN(1)) p_inproj<0>(a, lds, c);
    SEAM(1);
    if (IN(2)) p_dilated(a, lds, c);
    SEAM(2);
    if (IN(3)) { p_poolgemm(a, lds, c); p_merge(a, c); }
    SEAM(3);
    if (IN(4)) p_outproj<0>(a, lds, c);
    SEAM(4);
    if (IN(5)) resid_rows(a.x, YB, a.gains + D_MODEL, nullptr, nullptr, nullptr, a.gains + 2 * D_MODEL, HN2B, c.gw, c.NGW, c.lane);
    SEAM(5);
    if (IN(6)) p_gateup(a, lds, c);
    SEAM(6);
    if (IN(7)) p_down(a, lds, c);
    SEAM(7);
    if (IN(8)) { resid_rows(a.x, YB, a.gains + D_MODEL, HN2B, a.gains + 3 * D_MODEL, a.out, a.gains + 4 * D_MODEL, HN1  , c.gw, c.NGW, c.lane);
                 convert_weights(a, 1, lds, c.gw, c.NGW, c.wid, c.lane); }
    SEAM(8);
    if (IN(9)) p_inproj<1>(a, lds, c);
    SEAM(9);
    if (IN(10)) p_mix_cd(a, lds, c);
    SEAM(10);
    if (IN(11)) p_outproj<1>(a, lds, c);
    SEAM(11);
    if (IN(12)) resid_rows(a.out, YB, a.gains + 5 * D_MODEL, nullptr, nullptr, nullptr, a.gains + 6 * D_MODEL, HN2B, c.gw, c.NGW, c.lane);
    SEAM(12);
    if (IN(13)) p_gateup(a, lds, c);
    SEAM(13);
    if (IN(14)) p_down(a, lds, c);
    SEAM(14);
    if (IN(15)) resid_rows(a.out, YB, a.gains + 5 * D_MODEL, HN2B, a.gains + 7 * D_MODEL, a.out, nullptr, nullptr, c.gw, c.NGW, c.lane);
#undef IN
#undef SEAM
}

extern "C" void kernel_launch(void* const* d_in, const int* in_sizes, int n_in, void* d_out, int out_size, void* d_ws, size_t ws_size, hipStream_t stream) {
    static int grid = 0;
    if (grid == 0) {
        if (n_in != 11 || in_sizes[0] != MTOK * D_MODEL || out_size != MTOK * D_MODEL || ws_size < WS_END) { fprintf(stderr, "kernel_launch: unexpected shapes / workspace (n_in %d, ws %zu)\n", n_in, ws_size); grid = -1; return; }
        int dev = 0, cus = 0, per_cu = 0;
        if (hipGetDevice(&dev) != hipSuccess || hipDeviceGetAttribute(&cus, hipDeviceAttributeMultiprocessorCount, dev) != hipSuccess) { grid = -1; return; }
        if (hipFuncSetAttribute((const void*)hybrid_fwd, hipFuncAttributeMaxDynamicSharedMemorySize, LDS_BYTES) != hipSuccess) { fprintf(stderr, "kernel_launch: hipFuncSetAttribute failed\n"); grid = -1; return; }
        if (hipOccupancyMaxActiveBlocksPerMultiprocessor(&per_cu, (const void*)hybrid_fwd, 512, LDS_BYTES) != hipSuccess || per_cu < 1) { fprintf(stderr, "kernel_launch: occupancy query says %d\n", per_cu); per_cu = 1; }
        (void)hipGetLastError();
        grid = cus;
    }
    if (grid < 0) return;
    Args a{};
    a.x = (const float*)d_in[0]; a.gains = (const float*)d_in[1]; a.w_in_ab = (const float*)d_in[2]; a.pool_w = (const float*)d_in[3]; a.pool_scale = (const float*)d_in[4];
    a.w_out_ab = (const float*)d_in[5]; a.w_in_cd = (const float*)d_in[6]; a.w_out_cd = (const float*)d_in[7]; a.ffn_gate = (const float*)d_in[8]; a.ffn_up = (const float*)d_in[9]; a.ffn_down = (const float*)d_in[10];
    a.out = (float*)d_out; a.ws = (unsigned char*)d_ws;
#if MK_ONE_LAUNCH
    if (hipMemsetAsync(d_ws, 0, 16384, stream) != hipSuccess) { fprintf(stderr, "kernel_launch: memset failed\n"); return; }
    a.ph_lo = 0; a.ph_hi = 16;
    void* args[] = {&a};
    hipError_t e = hipLaunchCooperativeKernel((const void*)hybrid_fwd, dim3(grid), dim3(512), args, LDS_BYTES, stream);
    if (e != hipSuccess) fprintf(stderr, "cooperative launch failed: %s (grid %d)\n", hipGetErrorString(e), grid);
#else
    for (int ph = 0; ph < MK_NPH; ++ph) for (int rep = 0; rep < ((((MK_REP) >> ph) & 1) ? 2 : 1); ++rep) { a.ph_lo = ph; a.ph_hi = ph + 1; hipLaunchKernelGGL(hybrid_fwd, dim3(grid), dim3(512), LDS_BYTES, stream, a); }
#endif
}
```
